# Optimizing an MI355X kernel written in HIP

```python
import math
import jax, jax.numpy as jnp
from jax import lax
import numpy as np

D_MODEL = 2048
BATCH = 2
SEQ = 8192
DEPTH = 4

N_EVEN = (DEPTH + 1) // 2
N_ODD = DEPTH // 2

A_HEAD = 64
A_HEADS = D_MODEL // 2 // A_HEAD
A_W = A_HEADS * A_HEAD
DECAY_LORA = 64
AAA_LORA = 64
MV_LORA = 32
LN_X_EPS = A_HEAD * 1e-5
B_HEAD = 64
B_HQ = D_MODEL // 2 // B_HEAD
B_HKV = 4
B_GROUP = B_HQ // B_HKV
B_W = B_HQ * B_HEAD
B_KVW = B_HKV * B_HEAD
WINDOW = 128
BLOCK = 128
ROPE_DIM = B_HEAD // 4
ROPE_THETA = 500000.0
C_CHUNK = 128
C_GROUPS = 16
C_W = D_MODEL
C_GW = C_W // C_GROUPS
RMS_EPS = 1e-5
LN_EPS = 1e-5

SHIFT_W = 3 * A_W + DECAY_LORA + AAA_LORA
E_COLS = SHIFT_W + A_W + B_W + 2 * B_KVW + B_W
O_COLS = 3 * C_W

kernel_name = 'hybrid_rwkv7_swa_sinks_sgu'


def rmsnorm(x, g):
    xf = x.astype(jnp.float32)
    y = xf * lax.rsqrt(jnp.mean(xf * xf, axis=-1, keepdims=True) + RMS_EPS)
    return (y * g.astype(jnp.float32)).astype(x.dtype)


def layernorm(x, w, b):
    xf = x.astype(jnp.float32)
    mean = jnp.mean(xf, axis=-1, keepdims=True)
    var = jnp.mean(jnp.square(xf - mean), axis=-1, keepdims=True)
    y = (xf - mean) * lax.rsqrt(var + LN_EPS)
    return (y * w.astype(jnp.float32) + b.astype(jnp.float32)).astype(x.dtype)


def token_shift(z, mu):
    prev = jnp.pad(z[:, :-1], ((0, 0), (1, 0), (0, 0)))
    return z + (prev - z) * mu


def wkv7_scan(r, w, k, v, a, b):
    f32 = jnp.float32
    xs = tuple(jnp.moveaxis(t.astype(f32), 1, 0) for t in (r, w, k, v, a, b))
    B_, _, H, N = r.shape
    s0 = jnp.zeros((B_, H, N, N), f32)

    def step(S, inp):
        r_t, w_t, k_t, v_t, a_t, b_t = inp
        sa = jnp.einsum('bhvk,bhk->bhv', S, a_t)
        S = S * w_t[:, :, None, :] + sa[..., None] * b_t[:, :, None, :] + v_t[..., None] * k_t[:, :, None, :]
        y = jnp.einsum('bhvk,bhk->bhv', S, r_t)
        return S, y

    _, ys = lax.scan(step, s0, xs)
    return jnp.moveaxis(ys, 0, 1)


def rwkv7_mix(z, mu, w0, w2, a0, a2, k_k, k_a, r_k, ln_w, ln_b, v_first, v0=None, v1=None, v2=None):
    B_, T, _ = z.shape
    z = token_shift(z, mu)
    r, k, v, xw, xa = jnp.split(z, [A_W, 2 * A_W, 3 * A_W, 3 * A_W + DECAY_LORA], axis=-1)
    w_log = -jax.nn.softplus(-(w0 + jnp.tanh(xw) @ w2)) - 0.5
    decay = jnp.exp(-jnp.exp(w_log.astype(jnp.float32)))
    a = jax.nn.sigmoid(a0 + xa @ a2)
    if v_first is None:
        v_first = v
    else:
        v = v + (v_first - v) * jax.nn.sigmoid(v0 + (v @ v1) @ v2)
    heads = lambda t: t.reshape(B_, T, A_HEADS, A_HEAD)
    kk = heads(k * k_k).astype(jnp.float32)
    kk = kk * lax.rsqrt(jnp.sum(kk * kk, axis=-1, keepdims=True) + 1e-12)
    k = k * (1 + (a - 1) * k_a)
    r_h, k_h, v_h, a_h = heads(r), heads(k), heads(v), heads(a)
    y = wkv7_scan(r_h, heads(decay), k_h, v_h, -kk, kk * a_h.astype(jnp.float32))
    mean = jnp.mean(y, axis=-1, keepdims=True)
    var = jnp.mean(jnp.square(y - mean), axis=-1, keepdims=True)
    y = ((y - mean) * lax.rsqrt(var + LN_X_EPS)).reshape(B_, T, A_W)
    y = y * ln_w.astype(jnp.float32) + ln_b.astype(jnp.float32)
    bonus = jnp.sum(r_h * k_h * r_k, axis=-1, keepdims=True) * v_h
    y = y + bonus.reshape(B_, T, A_W).astype(jnp.float32)
    return y.astype(z.dtype), v_first


def rope_partial(x, positions):
    half = ROPE_DIM // 2
    inv_freq = jnp.power(jnp.float32(ROPE_THETA), -jnp.arange(half, dtype=jnp.float32) / half)
    ang = positions.astype(jnp.float32)[..., None] * inv_freq
    cos = jnp.cos(ang)[:, :, None, :]
    sin = jnp.sin(ang)[:, :, None, :]
    xr = x[..., :ROPE_DIM].astype(jnp.float32)
    x1, x2 = xr[..., :half], xr[..., half:]
    rot = jnp.concatenate([x1 * cos - x2 * sin, x2 * cos + x1 * sin], axis=-1)
    return jnp.concatenate([rot.astype(x.dtype), x[..., ROPE_DIM:]], axis=-1)


def swa_sinks(q, k, v, sinks):
    B_, T, _, _ = q.shape
    nb = T // BLOCK
    qb = q.reshape(B_, nb, BLOCK, B_HKV, B_GROUP, B_HEAD)
    kb = k.reshape(B_, nb, BLOCK, B_HKV, B_HEAD)
    vb = v.reshape(B_, nb, BLOCK, B_HKV, B_HEAD)

    def with_prev(t):
        prev = jnp.pad(t[:, :-1], ((0, 0), (1, 0), (0, 0), (0, 0), (0, 0)))
        return jnp.concatenate([prev, t], axis=2)

    kw, vw = with_prev(kb), with_prev(vb)
    scale = 1.0 / math.sqrt(B_HEAD)
    s = jnp.einsum('bnqhgd,bnkhd->bnhgqk', qb, kw, preferred_element_type=jnp.float32) * scale
    qi = jnp.arange(BLOCK)[:, None] + BLOCK
    ki = jnp.arange(2 * BLOCK)[None, :]
    band = (ki <= qi) & (qi - ki < WINDOW)
    has_prev = (jnp.arange(nb)[:, None, None] > 0) | (ki >= BLOCK)[None]
    valid = band[None] & has_prev
    s = jnp.where(valid[None, :, None, None], s, -jnp.inf)
    sink = sinks.astype(jnp.float32).reshape(B_HKV, B_GROUP)[None, None, :, :, None, None]
    m = jnp.maximum(jnp.max(s, axis=-1, keepdims=True), sink)
    p = jnp.exp(s - m)
    p = p / (jnp.sum(p, axis=-1, keepdims=True) + jnp.exp(sink - m))
    o = jnp.einsum('bnhgqk,bnkhd->bnqhgd', p.astype(v.dtype), vw)
    return o.reshape(B_, T, B_W)


def chunked_sgu(u, v, ln_w, ln_b, ws, bs):
    B_, T, _ = u.shape
    nc = T // C_CHUNK
    v = layernorm(v, ln_w, ln_b)
    vc = v.reshape(B_, nc, C_CHUNK, C_GROUPS, C_GW)
    causal = jnp.tril(jnp.ones((C_CHUNK, C_CHUNK), dtype=bool))
    wm = jnp.where(causal[None], ws, jnp.zeros_like(ws))
    mixed = jnp.einsum('gts,bnsgc->bntgc', wm, vc) + bs.T[None, None, :, :, None]
    return u * mixed.reshape(B_, T, C_W)


def setup_inputs(seed: int = 0) -> dict:
    key = jax.random.key(seed)
    ks = iter(jax.random.split(key, 32))
    nrm = lambda shape, s: jax.random.normal(next(ks), shape, jnp.float32) * s
    NE, NO = N_EVEN, N_ODD
    return {
        'x': nrm((BATCH, SEQ, D_MODEL), 1.0),
        'positions': (jax.random.randint(next(ks), (BATCH, 1), 0, 4096) + jnp.arange(SEQ)[None, :]).astype(jnp.int32),
        'e_norm': 1.0 + nrm((NE, D_MODEL), 0.02),
        'e_w_in': nrm((NE, D_MODEL, E_COLS), D_MODEL ** -0.5),
        'e_mu': jax.random.uniform(next(ks), (NE, SHIFT_W), jnp.float32),
        'rwkv_w0': jax.random.uniform(next(ks), (NE, A_W), jnp.float32, -6.0, -1.0),
        'rwkv_w2': nrm((NE, DECAY_LORA, A_W), 0.1 * DECAY_LORA ** -0.5),
        'rwkv_a0': nrm((NE, A_W), 0.1),
        'rwkv_a2': nrm((NE, AAA_LORA, A_W), 0.1 * AAA_LORA ** -0.5),
        'rwkv_k_k': 1.0 + nrm((NE, A_W), 0.1),
        'rwkv_k_a': 1.0 + nrm((NE, A_W), 0.1),
        'rwkv_r_k': nrm((NE, A_HEADS, A_HEAD), 0.1),
        'rwkv_ln_w': 1.0 + nrm((NE, A_W), 0.02),
        'rwkv_ln_b': nrm((NE, A_W), 0.01),
        'rwkv_v0': nrm((NE - 1, A_W), 0.1),
        'rwkv_v1': nrm((NE - 1, A_W, MV_LORA), A_W ** -0.5),
        'rwkv_v2': nrm((NE - 1, MV_LORA, A_W), 0.1 * MV_LORA ** -0.5),
        'attn_sinks': nrm((NE, B_HQ), 0.5),
        'e_w_out': nrm((NE, A_W + B_W, D_MODEL), (A_W + B_W) ** -0.5),
        'o_norm': 1.0 + nrm((NO, D_MODEL), 0.02),
        'o_w_in': nrm((NO, D_MODEL, O_COLS), D_MODEL ** -0.5),
        'sgu_ln_w': 1.0 + nrm((NO, C_W), 0.02),
        'sgu_ln_b': nrm((NO, C_W), 0.01),
        'sgu_ws': nrm((NO, C_GROUPS, C_CHUNK, C_CHUNK), C_CHUNK ** -0.5),
        'sgu_bs': 1.0 + nrm((NO, C_GROUPS, C_CHUNK), 0.1),
        'o_w_out': nrm((NO, C_W, D_MODEL), C_W ** -0.5),
        'final_norm': 1.0 + nrm((D_MODEL,), 0.02),
    }


def reference(x, positions, e_norm, e_w_in, e_mu, rwkv_w0, rwkv_w2, rwkv_a0, rwkv_a2, rwkv_k_k, rwkv_k_a,
              rwkv_r_k, rwkv_ln_w, rwkv_ln_b, rwkv_v0, rwkv_v1, rwkv_v2, attn_sinks, e_w_out,
              o_norm, o_w_in, sgu_ln_w, sgu_ln_b, sgu_ws, sgu_bs, o_w_out, final_norm):
    B_, T, _ = x.shape
    v_first = None
    for layer in range(DEPTH):
        if layer % 2 == 0:
            e = layer // 2
            h = rmsnorm(x, e_norm[e])
            z = h @ e_w_in[e]
            a_in, a_gate, q, kB, vB, b_gate = jnp.split(
                z, [SHIFT_W, SHIFT_W + A_W, SHIFT_W + A_W + B_W, SHIFT_W + A_W + B_W + B_KVW,
                    SHIFT_W + A_W + B_W + 2 * B_KVW], axis=-1)
            if e == 0:
                yA, v_first = rwkv7_mix(a_in, e_mu[e], rwkv_w0[e], rwkv_w2[e], rwkv_a0[e], rwkv_a2[e],
                                        rwkv_k_k[e], rwkv_k_a[e], rwkv_r_k[e], rwkv_ln_w[e], rwkv_ln_b[e], None)
            else:
                yA, v_first = rwkv7_mix(a_in, e_mu[e], rwkv_w0[e], rwkv_w2[e], rwkv_a0[e], rwkv_a2[e],
                                        rwkv_k_k[e], rwkv_k_a[e], rwkv_r_k[e], rwkv_ln_w[e], rwkv_ln_b[e],
                                        v_first, rwkv_v0[e - 1], rwkv_v1[e - 1], rwkv_v2[e - 1])
            qh = rope_partial(q.reshape(B_, T, B_HQ, B_HEAD), positions)
            kh = rope_partial(kB.reshape(B_, T, B_HKV, B_HEAD), positions)
            vh = vB.reshape(B_, T, B_HKV, B_HEAD)
            yB = swa_sinks(qh, kh, vh, attn_sinks[e])
            y = jnp.concatenate([yA * jax.nn.silu(a_gate), yB * jax.nn.silu(b_gate)], axis=-1)
            x = x + y @ e_w_out[e]
        else:
            o = layer // 2
            h = rmsnorm(x, o_norm[o])
            z = h @ o_w_in[o]
            u, vv, gate = jnp.split(z, [C_W, 2 * C_W], axis=-1)
            y = chunked_sgu(u, vv, sgu_ln_w[o], sgu_ln_b[o], sgu_ws[o], sgu_bs[o]) * jax.nn.silu(gate)
            x = x + y @ o_w_out[o]
    return rmsnorm(x, final_norm)
```

```cpp
#include <hip/hip_runtime.h>
#include <cstdio>
#include <cstdint>

#ifndef ONE_LAUNCH
#define ONE_LAUNCH 0
#endif

namespace pg8 {
#define PG8_LAS __attribute__((address_space(3)))
typedef unsigned short bf16_t;
typedef short bf16x8 __attribute__((ext_vector_type(8)));
typedef float f32x4 __attribute__((ext_vector_type(4)));
typedef unsigned u32x4 __attribute__((ext_vector_type(4)));
constexpr int BM = 256, BK = 64, HALF = 128, HTB = HALF * BK * 2  , STAGE_BYTES = 8 * HTB, NXCD = 8, WGM = 8;

__host__ __device__ __forceinline__ int lds_byte(int r, int c) { const int st = (r >> 4) * 2 + (c >> 5), rr = r & 15, cc = c & 31, ob = rr * 64 + cc * 2; return st * 1024 + (ob ^ (((ob >> 9) & 1) << 5)); }
__host__ __device__ __forceinline__ void stage_rc(int b, int& R, int& C) { const int st = b / 1024, sb = b % 1024, swz = sb ^ (((sb >> 9) & 1) << 5); R = (st >> 1) * 16 + swz / 64; C = (st & 1) * 32 + (swz % 64) / 2; }
__host__ __device__ __forceinline__ int perm32(int rho) { const int n = rho >> 4, i = rho & 15; return 8 * (i >> 2) + 4 * n + (i & 3); }

struct Unit { int pm, pn; };
struct Gemm { const bf16_t* A; const bf16_t* Bt; int M, N, K; };

struct StaticOrder {
    int nM, nN, nwg, G, c;
    __host__ __device__ void init(int M, int N, int G_, int c_) { nM = M / BM; nN = N / BM; nwg = nM * nN; G = G_; c = c_; }
    __host__ __device__ bool next(int i, Unit& u) const {
        const long L = (long)i * G + c; if (L >= nwg) return false;
        int wgid = (int)L; { const int q = nwg / NXCD, r = nwg % NXCD, xcd = wgid % NXCD, off = wgid / NXCD; wgid = (xcd < r ? xcd * (q + 1) : r * (q + 1) + (xcd - r) * q) + off; }
        const int nig = WGM * nN, gid = wgid / nig, fm = gid * WGM, gsz = (nM - fm) < WGM ? (nM - fm) : WGM;
        u.pm = fm + ((wgid % nig) % gsz); u.pn = (wgid % nig) / gsz; return true;
    }
    __device__ __forceinline__ void a_ready(const Unit&) const {}
    __device__ __forceinline__ void done(const Unit&) const {}
};

__device__ __forceinline__ unsigned cvt_pk_bf16(float lo, float hi) { unsigned r; asm("v_cvt_pk_bf16_f32 %0, %1, %2" : "=v"(r) : "v"(lo), "v"(hi)); return r; }


struct EpiZ {
    static constexpr bool PERM = true, AFTER_DRAIN = false;
    bf16_t* Z; int ldz; const float* ssq; float* st1; float* st2; int st_lo, st_hi;
    __device__ __forceinline__ void operator()(const f32x4 (&acc)[2][2][4][2], const Unit& u, int wr, int wc, int fr, int fq) const {
        const int row0 = u.pm * BM + wr * 64 + fr, col0 = u.pn * BM + wc * 32 + 8 * fq;
        const bool dost = (u.pn >= st_lo) && (u.pn < st_hi);
#pragma unroll
        for (int ai = 0; ai < 2; ++ai)
#pragma unroll
            for (int m = 0; m < 4; ++m) {
                const int row = row0 + ai * HALF + m * 16;
                const float rs = __builtin_amdgcn_rsqf(ssq[row] * (1.0f / 2048.0f) + 1e-5f);
                bf16_t* rowp = Z + (size_t)row * ldz + col0;
                float s1 = 0.f, s2 = 0.f;
#pragma unroll
                for (int bj = 0; bj < 2; ++bj) {
                    const f32x4 v0 = acc[ai][bj][m][0] * rs, v1 = acc[ai][bj][m][1] * rs;
                    u32x4 w; w.x = cvt_pk_bf16(v0[0], v0[1]); w.y = cvt_pk_bf16(v0[2], v0[3]); w.z = cvt_pk_bf16(v1[0], v1[1]); w.w = cvt_pk_bf16(v1[2], v1[3]);
                    *(u32x4*)(rowp + bj * HALF) = w;
                    s1 += (v0[0] + v0[1]) + (v0[2] + v0[3]) + (v1[0] + v1[1]) + (v1[2] + v1[3]);
                    s2 += (v0[0] * v0[0] + v0[1] * v0[1]) + (v0[2] * v0[2] + v0[3] * v0[3]) + (v1[0] * v1[0] + v1[1] * v1[1]) + (v1[2] * v1[2] + v1[3] * v1[3]);
                }
                if (dost) {
                    s1 += __shfl_xor(s1, 16); s1 += __shfl_xor(s1, 32); s2 += __shfl_xor(s2, 16); s2 += __shfl_xor(s2, 32);
                    if (fq == 0) { atomicAdd(st1 + row, s1); atomicAdd(st2 + row, s2); }
                }
            }
    }
};
struct EpiX {
    static constexpr bool PERM = true, AFTER_DRAIN = false;
    const float* xin; float* xout; bf16_t* xb; float* ssq_next;
    __device__ __forceinline__ void operator()(const f32x4 (&acc)[2][2][4][2], const Unit& u, int wr, int wc, int fr, int fq) const {
        const int row0 = u.pm * BM + wr * 64 + fr, col0 = u.pn * BM + wc * 32 + 8 * fq;
#pragma unroll
        for (int ai = 0; ai < 2; ++ai)
#pragma unroll
            for (int m = 0; m < 4; ++m) {
                const int row = row0 + ai * HALF + m * 16;
                const size_t off = (size_t)row * 2048 + col0;
                float s2 = 0.f;
#pragma unroll
                for (int bj = 0; bj < 2; ++bj) {
                    const f32x4 a = *(const f32x4*)(xin + off + bj * HALF), b = *(const f32x4*)(xin + off + bj * HALF + 4);
                    const f32x4 v0 = acc[ai][bj][m][0] + a, v1 = acc[ai][bj][m][1] + b;
                    *(f32x4*)(xout + off + bj * HALF) = v0; *(f32x4*)(xout + off + bj * HALF + 4) = v1;
                    u32x4 w; w.x = cvt_pk_bf16(v0[0], v0[1]); w.y = cvt_pk_bf16(v0[2], v0[3]); w.z = cvt_pk_bf16(v1[0], v1[1]); w.w = cvt_pk_bf16(v1[2], v1[3]);
                    *(u32x4*)(xb + off + bj * HALF) = w;
                    s2 += (v0[0] * v0[0] + v0[1] * v0[1]) + (v0[2] * v0[2] + v0[3] * v0[3]) + (v1[0] * v1[0] + v1[1] * v1[1]) + (v1[2] * v1[2] + v1[3] * v1[3]);
                }
                s2 += __shfl_xor(s2, 16); s2 += __shfl_xor(s2, 32);
                if (fq == 0) atomicAdd(ssq_next + row, s2);
                asm volatile("" ::: "memory");
            }
    }
};
template <class Epi, class Sched, bool ALIGN_EPI = false, bool SP2 = false>
__device__ __forceinline__ void gemm_phase(PG8_LAS unsigned char* lds, const Gemm g, const Sched& S, const Epi& E, const int tid) {
    const int wid = __builtin_amdgcn_readfirstlane(tid >> 6), lane = tid & 63, wr = wid >> 2, wc = wid & 3, fr = lane & 15, fq = lane >> 4;
    const int K = g.K, nt = K / BK;
    unsigned voffA[2], voffB[2];
#pragma unroll
    for (int i = 0; i < 2; ++i) { int R, C; stage_rc(tid * 16 + i * 8192, R, C); const int Rb = Epi::PERM ? ((R & ~31) + perm32(R & 31)) : R;
        voffA[i] = (unsigned)(R * K + C) * 2u; voffB[i] = (unsigned)(Rb * K + C) * 2u; }
    const size_t kstep = (size_t)(BK * 2);
    const size_t hstep = (size_t)HALF * K * 2;
    const size_t tstep = 2 * hstep;
    const unsigned ldsw = (unsigned)wid * 1024u;
    const int aoff = lds_byte(wr * 64 + fr, fq * 8), boff = lds_byte(wc * 32 + fr, fq * 8);
#define PG8_SA(b, h) (((b) * 2 + (h)) * HTB)
#define PG8_SB(b, h) ((4 + (b) * 2 + (h)) * HTB)
#define PG8_STAGE(bufoff, gbase, voff) do { _Pragma("unroll") for (int _i = 0; _i < 2; ++_i) \
        __builtin_amdgcn_global_load_lds((const unsigned*)((const char*)(gbase) + (voff)[_i]), (PG8_LAS unsigned*)(lds + (bufoff) + ldsw + _i * 8192), 16, 0, 0); } while (0)
#define PG8_LDA(dst, b, h) do { _Pragma("unroll") for (int m = 0; m < 4; ++m) _Pragma("unroll") for (int k = 0; k < 2; ++k) dst[m][k] = *(const PG8_LAS bf16x8*)(lds + PG8_SA(b, h) + aoff + m * 2048 + k * 1024); } while (0)
#define PG8_LDB(dst, b, h) do { _Pragma("unroll") for (int n = 0; n < 2; ++n) _Pragma("unroll") for (int k = 0; k < 2; ++k) dst[n][k] = *(const PG8_LAS bf16x8*)(lds + PG8_SB(b, h) + boff + n * 2048 + k * 1024); } while (0)
#define PG8_MMA(ai, bj, At, Bt) do { __builtin_amdgcn_s_setprio(1); _Pragma("unroll") for (int m = 0; m < 4; ++m) _Pragma("unroll") for (int n = 0; n < 2; ++n) _Pragma("unroll") for (int k = 0; k < 2; ++k) \
        acc[ai][bj][m][n] = __builtin_amdgcn_mfma_f32_16x16x32_bf16(Bt[n][k], At[m][k], acc[ai][bj][m][n], 0, 0, 0); __builtin_amdgcn_s_setprio(0); } while (0)
#define PG8_WAIT_V(n) asm volatile("s_waitcnt vmcnt(" #n ")" ::: "memory")
#define PG8_WAIT_L(n) asm volatile("s_waitcnt lgkmcnt(" #n ")" ::: "memory")
#define PG8_BAR __builtin_amdgcn_s_barrier()
#define PG8_SCHED __builtin_amdgcn_sched_barrier(0)
    Unit cur, nxt; int ui = 0;
    if (!S.next(0, cur)) return;
    f32x4 acc[2][2][4][2];
#pragma unroll
    for (int a = 0; a < 2; ++a)
#pragma unroll
        for (int b = 0; b < 2; ++b)
#pragma unroll
            for (int m = 0; m < 4; ++m)
#pragma unroll
                for (int n = 0; n < 2; ++n) acc[a][b][m][n] = (f32x4){0.f, 0.f, 0.f, 0.f};
    bf16x8 At[4][2], B0[2][2], B1[2][2];
    const char* cA = (const char*)g.A + (size_t)cur.pm * tstep; const char* cB = (const char*)g.Bt + (size_t)cur.pn * tstep;
    S.a_ready(cur);
    if constexpr (SP2) {
        PG8_STAGE(PG8_SB(0, 0), cB, voffB); PG8_STAGE(PG8_SB(0, 1), cB + hstep, voffB); PG8_STAGE(PG8_SA(0, 0), cA, voffA); PG8_STAGE(PG8_SA(0, 1), cA + hstep, voffA);
        if (wr == 1) PG8_BAR;
        PG8_WAIT_V(2); PG8_BAR;
        PG8_STAGE(PG8_SB(1, 0), cB + kstep, voffB); PG8_STAGE(PG8_SA(1, 0), cA + kstep, voffA); PG8_STAGE(PG8_SB(1, 1), cB + hstep + kstep, voffB);
        PG8_WAIT_V(6); PG8_BAR;
    } else {
        PG8_STAGE(PG8_SB(0, 0), cB, voffB); PG8_STAGE(PG8_SA(0, 0), cA, voffA); PG8_STAGE(PG8_SB(0, 1), cB + hstep, voffB); PG8_STAGE(PG8_SA(0, 1), cA + hstep, voffA);
        if (wr == 1) PG8_BAR;
        PG8_WAIT_V(4); PG8_BAR;
        PG8_STAGE(PG8_SB(1, 0), cB + kstep, voffB); PG8_STAGE(PG8_SA(1, 0), cA + kstep, voffA); PG8_STAGE(PG8_SB(1, 1), cB + hstep + kstep, voffB);
        PG8_WAIT_V(6); PG8_BAR;
    }
    for (;;) {
        const bool has_next = S.next(ui + 1, nxt);
        const char* nA = has_next ? (const char*)g.A + (size_t)nxt.pm * tstep : cA; const char* nB = has_next ? (const char*)g.Bt + (size_t)nxt.pn * tstep : cB;
        for (int t = 0; t < nt; t += 2) {
            const bool last = (t == nt - 2);
            const char* a1 = cA + (size_t)(t + 1) * kstep;
            const char* a2 = last ? nA : cA + (size_t)(t + 2) * kstep; const char* b2 = last ? nB : cB + (size_t)(t + 2) * kstep;
            const char* a3 = a2 + kstep; const char* b3 = b2 + kstep;
            if (last && has_next) S.a_ready(nxt);
            if constexpr (SP2) {
            PG8_LDB(B0, 0, 0); PG8_LDB(B1, 0, 1); PG8_SCHED; PG8_LDA(At, 0, 0); PG8_STAGE(PG8_SA(1, 1), a1 + hstep, voffA);
            PG8_WAIT_V(8); PG8_WAIT_L(0); PG8_BAR; PG8_MMA(0, 0, At, B0); PG8_MMA(0, 1, At, B1); PG8_BAR; PG8_SCHED;
            PG8_LDA(At, 0, 1); PG8_STAGE(PG8_SB(0, 0), b2, voffB); PG8_STAGE(PG8_SB(0, 1), b2 + hstep, voffB); PG8_STAGE(PG8_SA(0, 0), a2, voffA);
            PG8_WAIT_V(8); PG8_WAIT_L(0); PG8_BAR; PG8_MMA(1, 0, At, B0); PG8_MMA(1, 1, At, B1); PG8_BAR; PG8_SCHED;
            PG8_LDB(B0, 1, 0); PG8_LDB(B1, 1, 1); PG8_SCHED; PG8_LDA(At, 1, 0); PG8_STAGE(PG8_SA(0, 1), a2 + hstep, voffA);
            PG8_WAIT_V(8); PG8_WAIT_L(0); PG8_BAR; PG8_MMA(0, 0, At, B0); PG8_MMA(0, 1, At, B1); PG8_BAR; PG8_SCHED;
            PG8_LDA(At, 1, 1); PG8_STAGE(PG8_SB(1, 0), b3, voffB); PG8_STAGE(PG8_SB(1, 1), b3 + hstep, voffB); PG8_STAGE(PG8_SA(1, 0), a3, voffA);
            PG8_WAIT_V(8); PG8_WAIT_L(0); PG8_BAR; PG8_MMA(1, 0, At, B0); PG8_MMA(1, 1, At, B1); PG8_BAR; PG8_SCHED;
            } else {
            PG8_LDB(B0, 0, 0); PG8_SCHED; PG8_LDA(At, 0, 0); PG8_STAGE(PG8_SA(1, 1), a1 + hstep, voffA);
            PG8_WAIT_L(8); PG8_BAR; PG8_WAIT_L(0); PG8_MMA(0, 0, At, B0); PG8_BAR; PG8_SCHED;
            PG8_LDB(B1, 0, 1); PG8_STAGE(PG8_SB(0, 0), b2, voffB);
            PG8_BAR; PG8_WAIT_L(0); PG8_MMA(0, 1, At, B1); PG8_BAR;
            PG8_LDA(At, 0, 1); PG8_STAGE(PG8_SA(0, 0), a2, voffA);
            PG8_BAR; PG8_WAIT_L(0); PG8_MMA(1, 0, At, B0); PG8_BAR; PG8_SCHED;
            PG8_STAGE(PG8_SB(0, 1), b2 + hstep, voffB);
            PG8_WAIT_V(6); PG8_BAR; PG8_MMA(1, 1, At, B1); PG8_BAR;
            PG8_LDB(B0, 1, 0); PG8_SCHED; PG8_LDA(At, 1, 0); PG8_STAGE(PG8_SA(0, 1), a2 + hstep, voffA);
            PG8_WAIT_L(8); PG8_BAR; PG8_WAIT_L(0); PG8_MMA(0, 0, At, B0); PG8_BAR; PG8_SCHED;
            PG8_LDB(B1, 1, 1); PG8_STAGE(PG8_SB(1, 0), b3, voffB);
            PG8_BAR; PG8_WAIT_L(0); PG8_MMA(0, 1, At, B1); PG8_BAR;
            PG8_LDA(At, 1, 1); PG8_STAGE(PG8_SA(1, 0), a3, voffA);
            PG8_BAR; PG8_WAIT_L(0); PG8_MMA(1, 0, At, B0); PG8_BAR; PG8_SCHED;
            PG8_STAGE(PG8_SB(1, 1), b3 + hstep, voffB);
            PG8_WAIT_V(6); PG8_BAR; PG8_MMA(1, 1, At, B1); PG8_BAR;
            }
        }
        if constexpr (ALIGN_EPI) { if (wr == 0) PG8_BAR; }
        if constexpr (!Epi::AFTER_DRAIN) { E(acc, cur, wr, wc, fr, fq); S.done(cur); }
        if (!has_next) break;
#pragma unroll
        for (int a = 0; a < 2; ++a)
#pragma unroll
            for (int b = 0; b < 2; ++b)
#pragma unroll
                for (int m = 0; m < 4; ++m)
#pragma unroll
                    for (int n = 0; n < 2; ++n) acc[a][b][m][n] = (f32x4){0.f, 0.f, 0.f, 0.f};
        cur = nxt; cA = nA; cB = nB; ++ui;
        if constexpr (ALIGN_EPI) { if (wr == 1) PG8_BAR; }
    }
    PG8_WAIT_V(0);
    if constexpr (!ALIGN_EPI) { if (wr == 0) PG8_BAR; }
    PG8_BAR;
    if constexpr (Epi::AFTER_DRAIN) { E.fused(acc, cur, wr, wc, fr, fq, lds, wid, lane); S.done(cur); }
#undef PG8_SA
#undef PG8_SB
#undef PG8_STAGE
#undef PG8_LDA
#undef PG8_LDB
#undef PG8_MMA
#undef PG8_WAIT_V
#undef PG8_WAIT_L
#undef PG8_BAR
#undef PG8_SCHED
}
}

#ifndef PG8_SP2
#define PG8_SP2 true
#endif
#ifndef PG8_ALIGN
#define PG8_ALIGN true
#endif

constexpr int BATCH = 2, SEQ = 8192, DM = 2048, M = BATCH * SEQ;
constexpr int ZE = 6912, ZO = 6144, ECOLS = 6784, OCOLS = 6144;
constexpr int N_PHASES = 14;
constexpr int ZC_XW = 4096, ZC_XA = 4160, ZC_E1 = 4224, ZC_E2 = 4256, ZC_Q = 4352, ZC_KB = 5376, ZC_VB = 5632, ZC_BG = 5888;

constexpr size_t MiB = 1u << 20;
constexpr size_t WS_CTL = 0, CTL_ZERO_BYTES = 1 * MiB;
constexpr size_t WS_STAT = 1 * MiB;
constexpr size_t WS_ROPE = 2 * MiB;
constexpr size_t WS_WEIN = 4 * MiB;
constexpr size_t WS_WOIN = 31 * MiB;
constexpr size_t WS_WEOUT = 55 * MiB;
constexpr size_t WS_WOOUT = 71 * MiB;
constexpr size_t WS_XB = 87 * MiB;
constexpr size_t WS_Y = 151 * MiB;
constexpr size_t WS_VF = 215 * MiB;
constexpr size_t WS_Z = 247 * MiB;
constexpr size_t WS_END = 463 * MiB;
constexpr int CW_BAR = 4096;

constexpr int RING_OFF = 0, RING_BYTES = 131072;
constexpr int LDSCTL_OFF = RING_BYTES, MISC_OFF = LDSCTL_OFF + 320;
constexpr int LDS_BYTES = 147456;
constexpr int NWAVES = 8;
#define GAS __attribute__((address_space(1)))
#define LAS __attribute__((address_space(3)))
typedef unsigned short bf16;
typedef unsigned v4u __attribute__((ext_vector_type(4)));
typedef float f32x4 __attribute__((ext_vector_type(4)));
typedef short bf16x8 __attribute__((ext_vector_type(8)));
typedef GAS unsigned gu32;
typedef GAS unsigned long long gu64;
#define RLX_AGENT __ATOMIC_RELAXED, __HIP_MEMORY_SCOPE_AGENT
#define LDS_WAIT() asm volatile("s_waitcnt lgkmcnt(0)" ::: "memory")
#define VM_WAIT() asm volatile("s_waitcnt vmcnt(0)" ::: "memory")
__device__ __forceinline__ unsigned long long rt() { return __builtin_amdgcn_s_memrealtime(); }
__device__ __forceinline__ unsigned f2bf(float f) { unsigned u = __builtin_bit_cast(unsigned, f); return (u + 0x7fffu + ((u >> 16) & 1u)) >> 16; }
__device__ __forceinline__ unsigned pk2(float lo, float hi) { return f2bf(lo) | (f2bf(hi) << 16); }

#define XB_TMO      128
#define XB_XCNT(j)  (256  + 64 * (j))
#define XB_XSUB(j)  (1280 + 64 * (j))
#define XB_XGEN(j)  (2304 + 64 * (j))
#define XB_TOP      3328
#define XB_TOPGEN   3392
#define XCD_BAR_WORDS 3456
#define XB_SPIN_CAP (1u << 18)

__device__ __forceinline__ unsigned xb_ld(unsigned* p)              { return __hip_atomic_load(p, __ATOMIC_RELAXED, __HIP_MEMORY_SCOPE_AGENT); }
__device__ __forceinline__ unsigned xb_add(unsigned* p, unsigned v) { return __hip_atomic_fetch_add(p, v, __ATOMIC_RELAXED, __HIP_MEMORY_SCOPE_AGENT); }
__device__ __forceinline__ unsigned xb_xcc_id() { return (unsigned)__builtin_amdgcn_s_getreg((3 << 11) | 20) & 0xFu; }
#define XB_SPIN(cond, bar) do { unsigned _sp = 0; while (cond) { __builtin_amdgcn_s_sleep(1); \
    if ((++_sp & 255u) == 0u) { if (xb_ld(&(bar)[XB_TMO])) break; if (_sp > XB_SPIN_CAP) { atomicAdd(&(bar)[XB_TMO], 1u); break; } } } } while (0)

struct XcdBarrier {
    unsigned* bar; unsigned x;
    volatile LAS unsigned* st;
};

__device__ __forceinline__ XcdBarrier xcd_barrier_post(unsigned* bar, volatile LAS unsigned* st) {
    XcdBarrier b; b.bar = bar; b.x = xb_xcc_id(); b.st = st;
    if (threadIdx.x == 0) (void)xb_add(&bar[XB_XCNT(b.x)], 1u);
    return b;
}
__device__ __forceinline__ void xcd_barrier_complete(unsigned* bar, unsigned x, unsigned& nloc, unsigned& nx) {
    const unsigned G = gridDim.x * gridDim.y * gridDim.z;
    unsigned sum, cnt, mine, sp = 0u;
    for (;;) {
        sum = 0u; cnt = 0u; mine = 0u;
#pragma unroll
        for (unsigned j = 0; j < 16; ++j) { const unsigned c = xb_ld(&bar[XB_XCNT(j)]); sum += c; cnt += (c > 0u) ? 1u : 0u; mine = (j == x) ? c : mine; }
        if (sum == G) break;
        __builtin_amdgcn_s_sleep(1);
        if ((++sp & 255u) == 0u) { if (xb_ld(&bar[XB_TMO])) break; if (sp > XB_SPIN_CAP) { atomicAdd(&bar[XB_TMO], 1u); break; } }
    }
    nloc = mine > 0u ? mine : 1u; nx = cnt > 0u ? cnt : 1u;
}

__device__ __forceinline__ void xcd_barrier(const XcdBarrier& b, const int tid) {
    asm volatile("s_waitcnt vmcnt(0)" ::: "memory");
    __syncthreads();
    if (tid == 0) {
        unsigned* bar = b.bar;
        __builtin_amdgcn_s_waitcnt(0);
        unsigned nloc = b.st[0], nx = b.st[1];
        if (nloc == 0u) { xcd_barrier_complete(bar, b.x, nloc, nx); b.st[0] = nloc; b.st[1] = nx; }
        const unsigned old = xb_add(&bar[XB_XSUB(b.x)], 1u);
        const unsigned gen = old / nloc;
        if (old + 1u == (gen + 1u) * nloc) {
            __builtin_amdgcn_fence(__ATOMIC_RELEASE, "agent");
            asm volatile("s_waitcnt vmcnt(0)" ::: "memory");
            const unsigned og = xb_add(&bar[XB_TOP], 1u);
            const unsigned tg = og / nx;
            if (og + 1u == (tg + 1u) * nx) xb_add(&bar[XB_TOPGEN], 1u);
            else XB_SPIN(xb_ld(&bar[XB_TOPGEN]) == tg, bar);
            __builtin_amdgcn_fence(__ATOMIC_ACQUIRE, "agent");
            xb_add(&bar[XB_XGEN(b.x)], 1u);
            asm volatile("s_waitcnt vmcnt(0)" ::: "memory");
        } else {
            XB_SPIN(xb_ld(&bar[XB_XGEN(b.x)]) == gen, bar);
            __builtin_amdgcn_fence(__ATOMIC_ACQUIRE, "agent");
            asm volatile("s_waitcnt vmcnt(0)" ::: "memory");
        }
    }
    __syncthreads();
}

typedef float f32x2 __attribute__((ext_vector_type(2)));
typedef unsigned u32x2 __attribute__((ext_vector_type(2)));
__device__ __forceinline__ float bflo(unsigned w) { return __uint_as_float(w << 16); }
__device__ __forceinline__ float bfhi(unsigned w) { return __uint_as_float(w & 0xffff0000u); }
__device__ __forceinline__ float bf2f(bf16 b) { return __uint_as_float((unsigned)b << 16); }
__device__ __forceinline__ unsigned pkbf(float lo, float hi) { unsigned r; asm("v_cvt_pk_bf16_f32 %0, %1, %2" : "=v"(r) : "v"(lo), "v"(hi)); return r; }
template <int CTRL> __device__ __forceinline__ float dppf(float x) { return __int_as_float(__builtin_amdgcn_update_dpp(0, __float_as_int(x), CTRL, 0xF, 0xF, true)); }
#define DPP_XOR1 0xB1
#define DPP_XOR2 0x4E
#define DPP_HMIRROR 0x141
#define DPP_MIRROR 0x140
__device__ __forceinline__ float red4(float s) { s += dppf<DPP_XOR1>(s); s += dppf<DPP_XOR2>(s); return s; }
__device__ __forceinline__ float red8(float s) { s = red4(s); s += dppf<DPP_HMIRROR>(s); return s; }
__device__ __forceinline__ float red16(float s) { s = red8(s); s += dppf<DPP_MIRROR>(s); return s; }
__device__ __forceinline__ float max4(float s) { s = fmaxf(s, dppf<DPP_XOR1>(s)); s = fmaxf(s, dppf<DPP_XOR2>(s)); return s; }
__device__ __forceinline__ float wave_sum(float v) {
#pragma unroll
    for (int o = 1; o < 64; o <<= 1) v += __shfl_xor(v, o);
    return v;
}
__device__ __forceinline__ float sigmoidf_(float x) { return 1.0f / (1.0f + __expf(-x)); }
__device__ __forceinline__ float siluf_(float x) { return x / (1.0f + __expf(-x)); }

__device__ __forceinline__ int emap(int c) {
    if (c < 3072) { const int seg = c >> 10, cc = c & 1023; return (cc >> 6) * 256 + seg * 64 + (cc & 63); }
    if (c < 3136) return ZC_XW + (c - 3072);
    if (c < 3200) return ZC_XA + (c - 3136);
    if (c < 4224) { const int cc = c - 3200; return (cc >> 6) * 256 + 192 + (cc & 63); }
    if (c < 5248) return ZC_Q + (c - 4224);
    if (c < 5504) return ZC_KB + (c - 5248);
    if (c < 5760) return ZC_VB + (c - 5504);
    return ZC_BG + (c - 5760);
}
__device__ __forceinline__ void conv_weight(const float* W, int Nsrc, const float* g, bf16* WT, bool evenmap, LAS float* scr, int gw, int NGW, int lane) {
    const int nblk = Nsrc / 32, nitems = 32 * nblk;
    for (int it = gw; it < nitems; it += NGW) {
        const int kb = it / nblk, nb = it % nblk, k0 = 64 * kb, n0 = 32 * nb;
        const int drow = evenmap ? emap(n0) : n0;
#pragma unroll 8
        for (int i = 0; i < 32; ++i) { const int kk = 2 * i + (lane >> 5); float v = W[(size_t)(k0 + kk) * Nsrc + n0 + (lane & 31)]; if (g) v *= g[k0 + kk]; scr[kk * 33 + (lane & 31)] = v; }
        LDS_WAIT(); asm volatile("" ::: "memory");
        const int c = lane & 7;
#pragma unroll
        for (int j = 0; j < 4; ++j) { const int n = (lane >> 3) + 8 * j; const LAS float* s = scr + (8 * c) * 33 + n;
            v4u o; o.x = pkbf(s[0 * 33], s[1 * 33]); o.y = pkbf(s[2 * 33], s[3 * 33]); o.z = pkbf(s[4 * 33], s[5 * 33]); o.w = pkbf(s[6 * 33], s[7 * 33]);
            *(GAS v4u*)(WT + (size_t)(drow + n) * 2048 + k0 + 8 * c) = o; }
        LDS_WAIT(); asm volatile("" ::: "memory");
    }
}
__device__ __forceinline__ void zero_rows(bf16* WT, int r0, int r1, int gtid, int NGT) {
    const size_t n16 = (size_t)(r1 - r0) * 2048 / 8;
    GAS v4u* p = (GAS v4u*)(WT + (size_t)r0 * 2048);
    for (size_t i = gtid; i < n16; i += NGT) p[i] = (v4u){0u, 0u, 0u, 0u};
}
__device__ __forceinline__ void conv_e12(const float* W  , const float* g  , const float* muv  , const float* v1  , bf16* WT, int gw, int NGW, int lane) {
    const int which = lane >> 5, j = lane & 31;
    for (int k = gw; k < 2048; k += NGW) {
        const float* wrow = W + (size_t)k * ECOLS + 2048;
        float acc = 0.f;
        for (int c0 = 0; c0 < 1024; c0 += 64) {
            const float wv = wrow[c0 + lane], mu = muv[c0 + lane];
            const float xa = wv * (1.0f - mu), xb = wv * mu;
#pragma unroll
            for (int i = 0; i < 64; ++i) {
                const float sa = __int_as_float(__builtin_amdgcn_readlane(__float_as_int(xa), i)), sb = __int_as_float(__builtin_amdgcn_readlane(__float_as_int(xb), i));
                acc += (which ? sb : sa) * v1[(c0 + i) * 32 + j];
            }
        }
        WT[(size_t)(ZC_E1 + lane) * 2048 + k] = (bf16)f2bf(acc * g[k]);
    }
}

struct RwkvP { const float *mu, *w0, *w2, *a0, *a2, *kk, *ka, *rk, *lnw, *lnb, *v0, *v2; int e; };
__device__ __forceinline__ void rwkv_v1(LAS unsigned char* lds, const RwkvP P, int b, int h, const bf16* Z, bf16* Y, bf16* VF, int tid) {
    LAS float* W2S = (LAS float*)(lds);
    LAS float* A2S = (LAS float*)(lds + 16384);
    LAS float* V2S = (LAS float*)(lds + 32768);
    LAS float* TXW = (LAS float*)(lds + 40960);
    LAS float* XAS = (LAS float*)(lds + 49152);
    LAS float* EES = (LAS float*)(lds + 57344);
    LAS float* SR = (LAS float*)(lds + 61440);
    LAS float* SW = SR + 2048; LAS float* SK = SW + 2048; LAS float* SA = SK + 2048; LAS float* SB = SA + 2048; LAS float* SV = SB + 2048; LAS float* YS = SV + 2048;
    LAS float* BON = YS + 2048;
    const int e = P.e, hc = h * 64;
    for (int i = tid; i < 4096; i += 512) { const int j = i >> 6, c = i & 63; W2S[i] = P.w2[(size_t)j * 1024 + hc + c]; A2S[i] = P.a2[(size_t)j * 1024 + hc + c]; }
    if (e > 0) for (int i = tid; i < 2048; i += 512) { const int j = i >> 6, c = i & 63; V2S[i] = P.v2[(size_t)j * 1024 + hc + c]; }
    const int tk = tid >> 4, cg = tid & 15, c4 = 4 * cg;
    const int row = tid >> 3, kg = tid & 7;
    float mur[4], muk[4], muv[4], muw[4], mua[4], w0c[4], a0c[4], kkc[4], kac[4], rkc[4], lnw[4], lnb[4], v0c[4];
#pragma unroll
    for (int i = 0; i < 4; ++i) {
        mur[i] = P.mu[hc + c4 + i]; muk[i] = P.mu[1024 + hc + c4 + i]; muv[i] = P.mu[2048 + hc + c4 + i]; muw[i] = P.mu[3072 + c4 + i]; mua[i] = P.mu[3136 + c4 + i];
        w0c[i] = P.w0[hc + c4 + i]; a0c[i] = P.a0[hc + c4 + i]; kkc[i] = P.kk[hc + c4 + i]; kac[i] = P.ka[hc + c4 + i]; rkc[i] = P.rk[hc + c4 + i];
        lnw[i] = P.lnw[hc + c4 + i]; lnb[i] = P.lnb[hc + c4 + i]; v0c[i] = e > 0 ? P.v0[hc + c4 + i] : 0.f;
    }
    float S[8];
#pragma unroll
    for (int i = 0; i < 8; ++i) S[i] = 0.f;
    __syncthreads();
    for (int t0 = 0; t0 < SEQ; t0 += 32) {
        const int t = t0 + tk; const size_t m = (size_t)b * SEQ + t;
        const bf16* zr = Z + m * ZE; const bf16* zp = zr - ZE; const bool hp = t > 0;
        float xr[4], xk[4], xv[4];
        {
            const u32x2 r2 = *(const u32x2*)(zr + h * 256 + c4), k2 = *(const u32x2*)(zr + h * 256 + 64 + c4), v2 = *(const u32x2*)(zr + h * 256 + 128 + c4);
            const u32x2 w2 = *(const u32x2*)(zr + ZC_XW + c4), a2 = *(const u32x2*)(zr + ZC_XA + c4);
            u32x2 pr = {0u, 0u}, pk = {0u, 0u}, pv = {0u, 0u}, pw = {0u, 0u}, pa = {0u, 0u};
            if (hp) { pr = *(const u32x2*)(zp + h * 256 + c4); pk = *(const u32x2*)(zp + h * 256 + 64 + c4); pv = *(const u32x2*)(zp + h * 256 + 128 + c4); pw = *(const u32x2*)(zp + ZC_XW + c4); pa = *(const u32x2*)(zp + ZC_XA + c4); }
            const float cr[4] = {bflo(r2.x), bfhi(r2.x), bflo(r2.y), bfhi(r2.y)}, qr[4] = {bflo(pr.x), bfhi(pr.x), bflo(pr.y), bfhi(pr.y)};
            const float ck[4] = {bflo(k2.x), bfhi(k2.x), bflo(k2.y), bfhi(k2.y)}, qk[4] = {bflo(pk.x), bfhi(pk.x), bflo(pk.y), bfhi(pk.y)};
            const float cv[4] = {bflo(v2.x), bfhi(v2.x), bflo(v2.y), bfhi(v2.y)}, qv[4] = {bflo(pv.x), bfhi(pv.x), bflo(pv.y), bfhi(pv.y)};
            const float cw[4] = {bflo(w2.x), bfhi(w2.x), bflo(w2.y), bfhi(w2.y)}, qw[4] = {bflo(pw.x), bfhi(pw.x), bflo(pw.y), bfhi(pw.y)};
            const float ca[4] = {bflo(a2.x), bfhi(a2.x), bflo(a2.y), bfhi(a2.y)}, qa[4] = {bflo(pa.x), bfhi(pa.x), bflo(pa.y), bfhi(pa.y)};
#pragma unroll
            for (int i = 0; i < 4; ++i) {
                xr[i] = cr[i] + (qr[i] - cr[i]) * mur[i]; xk[i] = ck[i] + (qk[i] - ck[i]) * muk[i]; xv[i] = cv[i] + (qv[i] - cv[i]) * muv[i];
                TXW[tk * 64 + c4 + i] = tanhf(cw[i] + (qw[i] - cw[i]) * muw[i]); XAS[tk * 64 + c4 + i] = ca[i] + (qa[i] - ca[i]) * mua[i];
            }
            if (e > 0 && cg < 8) {
                const u32x2 e1 = *(const u32x2*)(zr + ZC_E1 + c4); u32x2 e2 = {0u, 0u}; if (hp) e2 = *(const u32x2*)(zp + ZC_E2 + c4);
                EES[tk * 32 + c4 + 0] = bflo(e1.x) + bflo(e2.x); EES[tk * 32 + c4 + 1] = bfhi(e1.x) + bfhi(e2.x); EES[tk * 32 + c4 + 2] = bflo(e1.y) + bflo(e2.y); EES[tk * 32 + c4 + 3] = bfhi(e1.y) + bfhi(e2.y);
            }
        }
        __syncthreads();
        {
            f32x4 lw = {0.f, 0.f, 0.f, 0.f}, la = {0.f, 0.f, 0.f, 0.f}, lv = {0.f, 0.f, 0.f, 0.f};
#pragma unroll 8
            for (int j = 0; j < 64; ++j) { lw += TXW[tk * 64 + j] * *(const LAS f32x4*)(W2S + j * 64 + c4); la += XAS[tk * 64 + j] * *(const LAS f32x4*)(A2S + j * 64 + c4); }
            if (e > 0) {
#pragma unroll 8
                for (int j = 0; j < 32; ++j) lv += EES[tk * 32 + j] * *(const LAS f32x4*)(V2S + j * 64 + c4);
            }
            float kkr[4], kn[4], alr[4], vv[4], ss = 0.f, bon = 0.f;
            u32x2 vfw = {0u, 0u};
            if (e > 0) vfw = *(const u32x2*)(VF + m * 1024 + hc + c4);
            const float vf[4] = {bflo(vfw.x), bfhi(vfw.x), bflo(vfw.y), bfhi(vfw.y)};
#pragma unroll
            for (int i = 0; i < 4; ++i) {
                const float x = w0c[i] + lw[i];
                const float sp = (-x > 20.f) ? -x : log1pf(expf(-x));
                const float dec = expf(-expf(-sp - 0.5f));
                alr[i] = 1.0f / (1.0f + expf(-(a0c[i] + la[i])));
                vv[i] = (e > 0) ? xv[i] + (vf[i] - xv[i]) * (1.0f / (1.0f + expf(-(v0c[i] + lv[i])))) : xv[i];
                kkr[i] = xk[i] * kkc[i]; ss += kkr[i] * kkr[i];
                kn[i] = xk[i] * (1.0f + (alr[i] - 1.0f) * kac[i]);
                bon += xr[i] * kn[i] * rkc[i];
                SR[tk * 64 + c4 + i] = xr[i]; SW[tk * 64 + c4 + i] = dec; SK[tk * 64 + c4 + i] = kn[i]; SV[tk * 64 + c4 + i] = vv[i];
            }
            if (e == 0) { u32x2 o; o.x = pkbf(xv[0], xv[1]); o.y = pkbf(xv[2], xv[3]); *(u32x2*)(VF + m * 1024 + hc + c4) = o; }
            ss = red16(ss); bon = red16(bon);
            const float inv = 1.0f / sqrtf(ss + 1e-12f);
#pragma unroll
            for (int i = 0; i < 4; ++i) { const float k1 = kkr[i] * inv; SA[tk * 64 + c4 + i] = -k1; SB[tk * 64 + c4 + i] = k1 * alr[i]; }
            if (cg == 0) BON[tk] = bon;
        }
        __syncthreads();
        for (int s = 0; s < 32; ++s) {
            const f32x4 a0 = *(const LAS f32x4*)(SA + s * 64 + 8 * kg), a1 = *(const LAS f32x4*)(SA + s * 64 + 8 * kg + 4);
            const f32x4 w0 = *(const LAS f32x4*)(SW + s * 64 + 8 * kg), w1 = *(const LAS f32x4*)(SW + s * 64 + 8 * kg + 4);
            const f32x4 b0 = *(const LAS f32x4*)(SB + s * 64 + 8 * kg), b1 = *(const LAS f32x4*)(SB + s * 64 + 8 * kg + 4);
            const f32x4 k0 = *(const LAS f32x4*)(SK + s * 64 + 8 * kg), k1 = *(const LAS f32x4*)(SK + s * 64 + 8 * kg + 4);
            const f32x4 r0 = *(const LAS f32x4*)(SR + s * 64 + 8 * kg), r1 = *(const LAS f32x4*)(SR + s * 64 + 8 * kg + 4);
            const float vt = SV[s * 64 + row];
            float sa = (S[0] * a0[0] + S[1] * a0[1]) + (S[2] * a0[2] + S[3] * a0[3]) + (S[4] * a1[0] + S[5] * a1[1]) + (S[6] * a1[2] + S[7] * a1[3]);
            sa = red8(sa);
#pragma unroll
            for (int i = 0; i < 4; ++i) { S[i] = S[i] * w0[i] + sa * b0[i] + vt * k0[i]; S[4 + i] = S[4 + i] * w1[i] + sa * b1[i] + vt * k1[i]; }
            float y = (S[0] * r0[0] + S[1] * r0[1]) + (S[2] * r0[2] + S[3] * r0[3]) + (S[4] * r1[0] + S[5] * r1[1]) + (S[6] * r1[2] + S[7] * r1[3]);
            y = red8(y);
            if (kg == 0) YS[s * 64 + row] = y;
        }
        __syncthreads();
        {
            const f32x4 y4 = *(const LAS f32x4*)(YS + tk * 64 + c4), v4 = *(const LAS f32x4*)(SV + tk * 64 + c4);
            const float mean = red16((y4[0] + y4[1]) + (y4[2] + y4[3])) * (1.0f / 64.0f);
            const f32x4 d = y4 - mean;
            const float var = red16((d[0] * d[0] + d[1] * d[1]) + (d[2] * d[2] + d[3] * d[3])) * (1.0f / 64.0f);
            const float rstd = 1.0f / sqrtf(var + 64e-5f), bo = BON[tk];
            const u32x2 g2 = *(const u32x2*)(zr + h * 256 + 192 + c4);
            const float gt[4] = {bflo(g2.x), bfhi(g2.x), bflo(g2.y), bfhi(g2.y)};
            float o[4];
#pragma unroll
            for (int i = 0; i < 4; ++i) o[i] = (d[i] * rstd * lnw[i] + lnb[i] + bo * v4[i]) * siluf_(gt[i]);
            u32x2 ow; ow.x = pkbf(o[0], o[1]); ow.y = pkbf(o[2], o[3]);
            *(u32x2*)(Y + m * 2048 + hc + c4) = ow;
        }
    }
    __syncthreads();
}

__device__ __forceinline__ void attn_v1_unit(LAS unsigned char* lds, int b, int g, int n, const bf16* Z, bf16* Y, const float* COS, const float* SIN, const float* sinks, int tid) {
    LAS bf16* KS = (LAS bf16*)lds; LAS bf16* VS = (LAS bf16*)(lds + 36864);
    __syncthreads();
    {
        const int fr = tid >> 1, half = tid & 1; const int tt = (n - 1) * 128 + fr; const bool valid = tt >= 0;
        const size_t mk = (size_t)b * SEQ + (valid ? tt : 0);
        const bf16* kp = Z + mk * ZE + ZC_KB + g * 64 + 32 * half; const bf16* vp = Z + mk * ZE + ZC_VB + g * 64 + 32 * half;
        v4u k4[4], v4[4];
#pragma unroll
        for (int i = 0; i < 4; ++i) { k4[i] = valid ? *(const v4u*)(kp + 8 * i) : (v4u){0u, 0u, 0u, 0u}; v4[i] = valid ? *(const v4u*)(vp + 8 * i) : (v4u){0u, 0u, 0u, 0u}; }
        if (half == 0 && valid) {
            const f32x4 c0 = *(const f32x4*)(COS + mk * 8), c1 = *(const f32x4*)(COS + mk * 8 + 4), s0 = *(const f32x4*)(SIN + mk * 8), s1 = *(const f32x4*)(SIN + mk * 8 + 4);
            const float cs[8] = {c0[0], c0[1], c0[2], c0[3], c1[0], c1[1], c1[2], c1[3]}, sn[8] = {s0[0], s0[1], s0[2], s0[3], s1[0], s1[1], s1[2], s1[3]};
            float x1[8] = {bflo(k4[0].x), bfhi(k4[0].x), bflo(k4[0].y), bfhi(k4[0].y), bflo(k4[0].z), bfhi(k4[0].z), bflo(k4[0].w), bfhi(k4[0].w)};
            float x2[8] = {bflo(k4[1].x), bfhi(k4[1].x), bflo(k4[1].y), bfhi(k4[1].y), bflo(k4[1].z), bfhi(k4[1].z), bflo(k4[1].w), bfhi(k4[1].w)};
            float y1[8], y2[8];
#pragma unroll
            for (int i = 0; i < 8; ++i) { y1[i] = x1[i] * cs[i] - x2[i] * sn[i]; y2[i] = x2[i] * cs[i] + x1[i] * sn[i]; }
            k4[0] = (v4u){pkbf(y1[0], y1[1]), pkbf(y1[2], y1[3]), pkbf(y1[4], y1[5]), pkbf(y1[6], y1[7])};
            k4[1] = (v4u){pkbf(y2[0], y2[1]), pkbf(y2[2], y2[3]), pkbf(y2[4], y2[5]), pkbf(y2[6], y2[7])};
        }
#pragma unroll
        for (int i = 0; i < 4; ++i) { *(LAS v4u*)(KS + fr * 72 + 32 * half + 8 * i) = k4[i]; *(LAS v4u*)(VS + fr * 72 + 32 * half + 8 * i) = v4[i]; }
    }
    __syncthreads();
    const int ql = tid >> 2, j = tid & 3;
    const size_t m = (size_t)b * SEQ + n * 128 + ql;
    const f32x4 c0 = *(const f32x4*)(COS + m * 8), c1 = *(const f32x4*)(COS + m * 8 + 4), s0 = *(const f32x4*)(SIN + m * 8), s1 = *(const f32x4*)(SIN + m * 8 + 4);
    const float cs[8] = {c0[0], c0[1], c0[2], c0[3], c1[0], c1[1], c1[2], c1[3]}, sn[8] = {s0[0], s0[1], s0[2], s0[3], s1[0], s1[1], s1[2], s1[3]};
    const int kf0 = ql + 1 + 32 * j;
    for (int hh = 0; hh < 4; ++hh) {
        const int hq = 4 * g + hh; const float sink = sinks[hq];
        float q[64];
        {
            const bf16* qp = Z + m * ZE + ZC_Q + hq * 64;
#pragma unroll
            for (int i = 0; i < 8; ++i) { const v4u w = *(const v4u*)(qp + 8 * i); q[8 * i] = bflo(w.x); q[8 * i + 1] = bfhi(w.x); q[8 * i + 2] = bflo(w.y); q[8 * i + 3] = bfhi(w.y); q[8 * i + 4] = bflo(w.z); q[8 * i + 5] = bfhi(w.z); q[8 * i + 6] = bflo(w.w); q[8 * i + 7] = bfhi(w.w); }
#pragma unroll
            for (int i = 0; i < 8; ++i) { const float x1 = q[i], x2 = q[i + 8]; q[i] = x1 * cs[i] - x2 * sn[i]; q[i + 8] = x2 * cs[i] + x1 * sn[i]; }
#pragma unroll
            for (int i = 0; i < 64; ++i) q[i] *= 0.125f;
        }
        float mx = sink, l = 0.f; float o[64];
#pragma unroll
        for (int d = 0; d < 64; ++d) o[d] = 0.f;
        const int i0 = (n > 0) ? 0 : ((128 - kf0) > 0 ? (128 - kf0) : 0);
        for (int i = i0; i < 32; ++i) {
            const LAS bf16* kr = KS + (kf0 + i) * 72; float a = 0.f;
#pragma unroll
            for (int c = 0; c < 8; ++c) { const v4u w = *(const LAS v4u*)(kr + 8 * c);
                a += q[8 * c] * bflo(w.x) + q[8 * c + 1] * bfhi(w.x) + q[8 * c + 2] * bflo(w.y) + q[8 * c + 3] * bfhi(w.y) + q[8 * c + 4] * bflo(w.z) + q[8 * c + 5] * bfhi(w.z) + q[8 * c + 6] * bflo(w.w) + q[8 * c + 7] * bfhi(w.w); }
            const float mn = fmaxf(mx, a), al = __expf(mx - mn), p = __expf(a - mn); mx = mn; l = l * al + p;
            const LAS bf16* vr = VS + (kf0 + i) * 72;
#pragma unroll
            for (int c = 0; c < 8; ++c) { const v4u w = *(const LAS v4u*)(vr + 8 * c);
                o[8 * c] = o[8 * c] * al + p * bflo(w.x); o[8 * c + 1] = o[8 * c + 1] * al + p * bfhi(w.x); o[8 * c + 2] = o[8 * c + 2] * al + p * bflo(w.y); o[8 * c + 3] = o[8 * c + 3] * al + p * bfhi(w.y);
                o[8 * c + 4] = o[8 * c + 4] * al + p * bflo(w.z); o[8 * c + 5] = o[8 * c + 5] * al + p * bfhi(w.z); o[8 * c + 6] = o[8 * c + 6] * al + p * bflo(w.w); o[8 * c + 7] = o[8 * c + 7] * al + p * bfhi(w.w); }
        }
        const float ma = max4(mx), scl = __expf(mx - ma);
        l = red4(l * scl);
        const float inv = 1.0f / (l + __expf(sink - ma));
#pragma unroll
        for (int d = 0; d < 64; ++d) o[d] = red4(o[d] * scl) * inv;
        const bf16* gp = Z + m * ZE + ZC_BG + hq * 64; bf16* yp = Y + m * 2048 + 1024 + hq * 64;
#pragma unroll
        for (int jj = 0; jj < 4; ++jj) if (j == jj) {
#pragma unroll
            for (int hv = 0; hv < 2; ++hv) {
                const v4u gw = *(const v4u*)(gp + 16 * jj + 8 * hv);
                const float gt[8] = {bflo(gw.x), bfhi(gw.x), bflo(gw.y), bfhi(gw.y), bflo(gw.z), bfhi(gw.z), bflo(gw.w), bfhi(gw.w)};
                float r[8];
#pragma unroll
                for (int i = 0; i < 8; ++i) r[i] = o[16 * jj + 8 * hv + i] * siluf_(gt[i]);
                *(v4u*)(yp + 16 * jj + 8 * hv) = (v4u){pkbf(r[0], r[1]), pkbf(r[2], r[3]), pkbf(r[4], r[5]), pkbf(r[6], r[7])};
            }
        }
    }
}

struct SguP { const float *lnw, *lnb, *ws, *bs, *st1, *st2; };
__device__ __forceinline__ void sgu_v1(LAS unsigned char* lds, const SguP P, const bf16* Z, bf16* Y, int G, int tid) {
    LAS bf16* WMT = (LAS bf16*)lds; LAS float* VV = (LAS float*)(lds + 32768);
    const int ng = G / 16; if ((int)blockIdx.x >= ng * 16) return;
    const int g = blockIdx.x & 15;
    __syncthreads();
    for (int idx = tid; idx < 16384; idx += 512) { const int t = idx >> 7, s = idx & 127; const float v = (t >= s) ? P.ws[(size_t)g * 16384 + idx] : 0.f; WMT[s * 128 + t] = (bf16)f2bf(v); }
    const int tq = tid >> 4, cq = tid & 15;
    for (int p = blockIdx.x >> 4; p < 128; p += ng) {
        const int b = p >> 6, nc = p & 63; const size_t m0 = (size_t)b * SEQ + nc * 128;
        __syncthreads();
        {
            const int s = tid >> 2, qt = tid & 3; const size_t m = m0 + s;
            const float mean = P.st1[m] * (1.0f / 2048.0f), var = P.st2[m] * (1.0f / 2048.0f) - mean * mean, rstd = 1.0f / sqrtf(var + 1e-5f);
            const bf16* vp = Z + m * ZO + 2048 + g * 128 + 32 * qt; const float* lw = P.lnw + g * 128 + 32 * qt; const float* lb = P.lnb + g * 128 + 32 * qt;
#pragma unroll
            for (int i = 0; i < 4; ++i) { const v4u w = *(const v4u*)(vp + 8 * i);
                const float x[8] = {bflo(w.x), bfhi(w.x), bflo(w.y), bfhi(w.y), bflo(w.z), bfhi(w.z), bflo(w.w), bfhi(w.w)};
                const f32x4 w0 = *(const f32x4*)(lw + 8 * i), w1 = *(const f32x4*)(lw + 8 * i + 4), b0 = *(const f32x4*)(lb + 8 * i), b1 = *(const f32x4*)(lb + 8 * i + 4);
                f32x4 o0, o1;
#pragma unroll
                for (int k = 0; k < 4; ++k) { o0[k] = (x[k] - mean) * rstd * w0[k] + b0[k]; o1[k] = (x[4 + k] - mean) * rstd * w1[k] + b1[k]; }
                *(LAS f32x4*)(VV + s * 128 + 32 * qt + 8 * i) = o0; *(LAS f32x4*)(VV + s * 128 + 32 * qt + 8 * i + 4) = o1; }
        }
        __syncthreads();
        f32x4 acc[4][2];
#pragma unroll
        for (int i = 0; i < 4; ++i) { acc[i][0] = (f32x4){0.f, 0.f, 0.f, 0.f}; acc[i][1] = (f32x4){0.f, 0.f, 0.f, 0.f}; }
#pragma unroll 4
        for (int s = 0; s < 128; ++s) {
            const f32x4 v0 = *(const LAS f32x4*)(VV + s * 128 + 8 * cq), v1 = *(const LAS f32x4*)(VV + s * 128 + 8 * cq + 4);
#pragma unroll
            for (int i = 0; i < 4; ++i) { const float w = bf2f(WMT[s * 128 + tq + 32 * i]); acc[i][0] += w * v0; acc[i][1] += w * v1; }
        }
#pragma unroll
        for (int i = 0; i < 4; ++i) {
            const int t = tq + 32 * i; const size_t m = m0 + t; const float bsv = P.bs[g * 128 + t];
            const v4u uw = *(const v4u*)(Z + m * ZO + g * 128 + 8 * cq), gw = *(const v4u*)(Z + m * ZO + 4096 + g * 128 + 8 * cq);
            const float u[8] = {bflo(uw.x), bfhi(uw.x), bflo(uw.y), bfhi(uw.y), bflo(uw.z), bfhi(uw.z), bflo(uw.w), bfhi(uw.w)};
            const float gt[8] = {bflo(gw.x), bfhi(gw.x), bflo(gw.y), bfhi(gw.y), bflo(gw.z), bfhi(gw.z), bflo(gw.w), bfhi(gw.w)};
            float r[8];
#pragma unroll
            for (int k = 0; k < 4; ++k) { r[k] = u[k] * (acc[i][0][k] + bsv) * siluf_(gt[k]); r[4 + k] = u[4 + k] * (acc[i][1][k] + bsv) * siluf_(gt[4 + k]); }
            *(v4u*)(Y + m * 2048 + g * 128 + 8 * cq) = (v4u){pkbf(r[0], r[1]), pkbf(r[2], r[3]), pkbf(r[4], r[5]), pkbf(r[6], r[7])};
        }
    }
    __syncthreads();
}

struct Args { const void* in[27]; float* out; unsigned char* ws; int ph_lo, ph_hi, li, pad; };
enum { I_X = 0, I_POS, I_ENORM, I_EWIN, I_EMU, I_W0, I_W2, I_A0, I_A2, I_KK, I_KA, I_RK, I_LNW, I_LNB, I_V0, I_V1, I_V2, I_SINK, I_EWOUT, I_ONORM, I_OWIN, I_SLNW, I_SLNB, I_SWS, I_SBS, I_OWOUT, I_FNORM };

typedef const __attribute__((address_space(4))) Args* KArgP;
__device__ __forceinline__ KArgP kargs() { KArgP p = (KArgP)__builtin_amdgcn_kernarg_segment_ptr(); asm volatile("" : "+s"(p)); return p; }
__global__ void __launch_bounds__(NWAVES * 64, 2) hybrid_fwd(Args args_) {
    extern __shared__ __attribute__((aligned(16))) unsigned char lds_raw[];
    LAS unsigned char* lds = (LAS unsigned char*)lds_raw;
    volatile LAS unsigned* MISC = (volatile LAS unsigned*)(lds + MISC_OFF);
    const int wave = __builtin_amdgcn_readfirstlane(threadIdx.x >> 6);
    const int G = gridDim.x, gw = blockIdx.x * NWAVES + wave, NGW = G * NWAVES, NGT = G * NWAVES * 64;
    (void)args_;

    for (int u = threadIdx.x; u < (LDS_BYTES - LDSCTL_OFF) / 4; u += NWAVES * 64) ((LAS unsigned*)(lds + LDSCTL_OFF))[u] = 0u;
    __syncthreads();
    XcdBarrier bar; { KArgP a0 = kargs(); bar = xcd_barrier_post((unsigned*)(a0->ws + WS_CTL) + CW_BAR + a0->li * XCD_BAR_WORDS, MISC + 8); }
    LAS float* scr = (LAS float*)(lds + RING_OFF + wave * 16384);

    const int ph_lo = kargs()->ph_lo, ph_hi = kargs()->ph_hi;
    for (int ph = ph_lo; ph < ph_hi; ++ph) {
        KArgP args = kargs();
        int lane = (int)__builtin_amdgcn_mbcnt_hi(~0u, __builtin_amdgcn_mbcnt_lo(~0u, 0u)); asm volatile("" : "+v"(lane));
        const int tid = wave * 64 + lane, gtid = blockIdx.x * (NWAVES * 64) + tid;
        unsigned char* ws = args->ws;
        float* STAT = (float*)(ws + WS_STAT);
        float* COS = (float*)(ws + WS_ROPE); float* SIN = COS + (size_t)M * 8;
        bf16* WEIN = (bf16*)(ws + WS_WEIN); bf16* WOIN = (bf16*)(ws + WS_WOIN); bf16* WEOUT = (bf16*)(ws + WS_WEOUT); bf16* WOOUT = (bf16*)(ws + WS_WOOUT);
        bf16* XB = (bf16*)(ws + WS_XB); bf16* Y = (bf16*)(ws + WS_Y); bf16* VF = (bf16*)(ws + WS_VF); bf16* Z = (bf16*)(ws + WS_Z);
        const float* x_in = (const float*)args->in[I_X]; float* out = args->out;
        if (ph == 0) {
            for (int i = gtid; i < 8 * M; i += NGT) STAT[M + i] = 0.f;
            for (int m = gw; m < M; m += NGW) {
                const GAS f32x4* xr = (const GAS f32x4*)(x_in + (size_t)m * DM) + lane; GAS unsigned long long* o8 = (GAS unsigned long long*)(XB + (size_t)m * DM) + lane; float s = 0.f;
#pragma unroll
                for (int j = 0; j < 8; ++j) { const f32x4 v = xr[64 * j]; s += (v.x * v.x + v.y * v.y) + (v.z * v.z + v.w * v.w); o8[64 * j] = (unsigned long long)pkbf(v.x, v.y) | ((unsigned long long)pkbf(v.z, v.w) << 32); }
                s = wave_sum(s); if (lane == 0) STAT[m] = s;
            }
            { const int* pos = (const int*)args->in[I_POS];
              for (int i = gtid; i < M * 8; i += NGT) { const int m = i >> 3, k = i & 7; const float invf = powf(500000.0f, -(float)k * 0.125f); const float ang = (float)pos[m] * invf; COS[i] = cosf(ang); SIN[i] = sinf(ang); } }
            conv_weight((const float*)args->in[I_EWIN], ECOLS, (const float*)args->in[I_ENORM], WEIN, true, scr, gw, NGW, lane);
            zero_rows(WEIN, ZC_E1, ZC_Q, gtid, NGT);
            conv_weight((const float*)args->in[I_OWIN], OCOLS, (const float*)args->in[I_ONORM], WOIN, false, scr, gw, NGW, lane);
            conv_weight((const float*)args->in[I_EWOUT], 2048, nullptr, WEOUT, false, scr, gw, NGW, lane);
            conv_weight((const float*)args->in[I_EWOUT] + (size_t)2048 * 2048, 2048, nullptr, WEOUT + (size_t)2048 * 2048, false, scr, gw, NGW, lane);
            conv_weight((const float*)args->in[I_OWOUT], 2048, nullptr, WOOUT, false, scr, gw, NGW, lane);
            conv_weight((const float*)args->in[I_OWOUT] + (size_t)2048 * 2048, 2048, nullptr, WOOUT + (size_t)2048 * 2048, false, scr, gw, NGW, lane);
        } else if (ph == N_PHASES - 1) {
            const float* fn = (const float*)args->in[I_FNORM]; const float* ssq = STAT + (size_t)4 * M;
            for (int m = gw; m < M; m += NGW) {
                const float rs = 1.0f / sqrtf(ssq[m] * (1.0f / 2048.0f) + 1e-5f);
                GAS f32x4* xr = (GAS f32x4*)(out + (size_t)m * DM) + lane; const GAS f32x4* gr = (const GAS f32x4*)fn + lane;
#pragma unroll
                for (int j = 0; j < 8; ++j) { const f32x4 v = xr[64 * j], gg = gr[64 * j]; xr[64 * j] = v * rs * gg; }
            }
        } else {
            const int L = (ph - 1) / 3, sub = (ph - 1) % 3, idx = L >> 1; const bool even = (L & 1) == 0;
            if (sub == 0) {
                const int N = even ? ZE : ZO;
                pg8::Gemm g{XB, even ? WEIN : WOIN, M, N, DM}; pg8::StaticOrder S; S.init(M, N, G, (int)blockIdx.x);
                pg8::EpiZ E{Z, N, STAT + (size_t)L * M, STAT + (size_t)(5 + idx) * M, STAT + (size_t)(7 + idx) * M, even ? 0 : 8, even ? 0 : 16};
                pg8::gemm_phase<pg8::EpiZ, pg8::StaticOrder, PG8_ALIGN, PG8_SP2>(lds + RING_OFF, g, S, E, tid);
            } else if (sub == 2) {
                pg8::Gemm g{Y, (even ? WEOUT : WOOUT) + (size_t)idx * 2048 * 2048, M, DM, DM}; pg8::StaticOrder S; S.init(M, DM, G, (int)blockIdx.x);
                pg8::EpiX E{L == 0 ? x_in : out, out, XB, STAT + (size_t)(L + 1) * M};
                pg8::gemm_phase<pg8::EpiX, pg8::StaticOrder, PG8_ALIGN, PG8_SP2>(lds + RING_OFF, g, S, E, tid);
            } else if (even) {
                if (idx == 0) {
                    conv_weight((const float*)args->in[I_EWIN] + (size_t)2048 * ECOLS, ECOLS, (const float*)args->in[I_ENORM] + 2048, WEIN, true, scr, gw, NGW, lane);
                    zero_rows(WEIN, ZC_E2 + 32, ZC_Q, gtid, NGT);
                    conv_e12((const float*)args->in[I_EWIN] + (size_t)2048 * ECOLS, (const float*)args->in[I_ENORM] + 2048, (const float*)args->in[I_EMU] + 3200 + 2048, (const float*)args->in[I_V1], WEIN, gw, NGW, lane);
                    __syncthreads();
                }
                if ((int)blockIdx.x < 32) {
                    RwkvP P; P.e = idx;
                    P.mu = (const float*)args->in[I_EMU] + idx * 3200; P.w0 = (const float*)args->in[I_W0] + idx * 1024; P.w2 = (const float*)args->in[I_W2] + (size_t)idx * 64 * 1024;
                    P.a0 = (const float*)args->in[I_A0] + idx * 1024; P.a2 = (const float*)args->in[I_A2] + (size_t)idx * 64 * 1024; P.kk = (const float*)args->in[I_KK] + idx * 1024; P.ka = (const float*)args->in[I_KA] + idx * 1024;
                    P.rk = (const float*)args->in[I_RK] + idx * 1024; P.lnw = (const float*)args->in[I_LNW] + idx * 1024; P.lnb = (const float*)args->in[I_LNB] + idx * 1024;
                    P.v0 = (const float*)args->in[I_V0]; P.v2 = (const float*)args->in[I_V2];
                    rwkv_v1(lds + RING_OFF, P, (int)blockIdx.x >> 4, (int)blockIdx.x & 15, Z, Y, VF, tid);
                } else {
                    const float* sinks = (const float*)args->in[I_SINK] + idx * 16;
                    for (int u = (int)blockIdx.x - 32; u < 512; u += G - 32) attn_v1_unit(lds + RING_OFF, u >> 8, (u >> 6) & 3, u & 63, Z, Y, COS, SIN, sinks, tid);
                }
            } else {
                if (idx == 0) { conv_weight((const float*)args->in[I_OWIN] + (size_t)2048 * OCOLS, OCOLS, (const float*)args->in[I_ONORM] + 2048, WOIN, false, scr, gw, NGW, lane); __syncthreads(); }
                SguP P; P.lnw = (const float*)args->in[I_SLNW] + idx * 2048; P.lnb = (const float*)args->in[I_SLNB] + idx * 2048; P.ws = (const float*)args->in[I_SWS] + (size_t)idx * 16 * 16384; P.bs = (const float*)args->in[I_SBS] + idx * 2048;
                P.st1 = STAT + (size_t)(5 + idx) * M; P.st2 = STAT + (size_t)(7 + idx) * M;
                sgu_v1(lds + RING_OFF, P, Z, Y, G, tid);
            }
        }
        if (ph + 1 < ph_hi) xcd_barrier(bar, tid);
    }
}

extern "C" void kernel_launch(void* const* d_in, const int* in_sizes, int n_in, void* d_out, int out_size, void* d_ws, size_t ws_size, hipStream_t stream) {
    static int grid = 0;
    if (grid == 0) {
        if (n_in != 27 || in_sizes[0] != M * DM || out_size != M * DM || ws_size < WS_END) { fprintf(stderr, "kernel_launch: unexpected shapes (n_in %d, in0 %d, out %d, ws %zu); nothing launched\n", n_in, n_in > 0 ? in_sizes[0] : -1, out_size, ws_size); grid = -1; return; }
        int dev = 0, cus = 0, per_cu = 0;
        if (hipGetDevice(&dev) != hipSuccess || hipDeviceGetAttribute(&cus, hipDeviceAttributeMultiprocessorCount, dev) != hipSuccess) { fprintf(stderr, "kernel_launch: device query failed\n"); grid = -1; return; }
        if (hipFuncSetAttribute((const void*)hybrid_fwd, hipFuncAttributeMaxDynamicSharedMemorySize, LDS_BYTES) != hipSuccess) { fprintf(stderr, "kernel_launch: hipFuncSetAttribute failed\n"); grid = -1; return; }
        if (hipOccupancyMaxActiveBlocksPerMultiprocessor(&per_cu, (const void*)hybrid_fwd, NWAVES * 64, LDS_BYTES) != hipSuccess || per_cu < 1) fprintf(stderr, "kernel_launch: note: occupancy query reports %d workgroups per CU\n", per_cu);
        (void)hipGetLastError();
        grid = cus;
    }
    if (grid < 0) return;
    if (hipMemsetAsync((char*)d_ws + WS_CTL, 0, CTL_ZERO_BYTES, stream) != hipSuccess) { fprintf(stderr, "kernel_launch: memset failed\n"); return; }
    Args a{};
    for (int i = 0; i < 27; ++i) a.in[i] = d_in[i];
    a.out = (float*)d_out; a.ws = (unsigned char*)d_ws;
#if ONE_LAUNCH
    a.ph_lo = 0; a.ph_hi = N_PHASES; a.li = 0;
    hipLaunchKernelGGL(hybrid_fwd, dim3(grid), dim3(NWAVES * 64), LDS_BYTES, stream, a);
#else
    for (int p = 0; p < N_PHASES; ++p) { a.ph_lo = p; a.ph_hi = p + 1; a.li = p; hipLaunchKernelGGL(hybrid_fwd, dim3(grid), dim3(NWAVES * 64), LDS_BYTES, stream, a); }
#endif
    const hipError_t le = hipPeekAtLastError();
    if (le != hipSuccess) fprintf(stderr, "kernel_launch: launch failed: %s\n", hipGetErrorName(le));
}
```

```cpp
#include <hip/hip_runtime.h>
#include <cstdio>
#include <cstdint>

#ifndef ONE_LAUNCH
#define ONE_LAUNCH 1
#endif

namespace pg8 {
#define PG8_LAS __attribute__((address_space(3)))
typedef unsigned short bf16_t;
typedef short bf16x8 __attribute__((ext_vector_type(8)));
typedef float f32x4 __attribute__((ext_vector_type(4)));
typedef unsigned u32x4 __attribute__((ext_vector_type(4)));
constexpr int BM = 256, BK = 64, HALF = 128, HTB = HALF * BK * 2  , STAGE_BYTES = 8 * HTB, NXCD = 8, WGM = 8;

__host__ __device__ __forceinline__ int lds_byte(int r, int c) { const int st = (r >> 4) * 2 + (c >> 5), rr = r & 15, cc = c & 31, ob = rr * 64 + cc * 2; return st * 1024 + (ob ^ (((ob >> 9) & 1) << 5)); }
__host__ __device__ __forceinline__ void stage_rc(int b, int& R, int& C) { const int st = b / 1024, sb = b % 1024, swz = sb ^ (((sb >> 9) & 1) << 5); R = (st >> 1) * 16 + swz / 64; C = (st & 1) * 32 + (swz % 64) / 2; }
__host__ __device__ __forceinline__ int perm32(int rho) { const int n = rho >> 4, i = rho & 15; return 8 * (i >> 2) + 4 * n + (i & 3); }

struct Unit { int pm, pn; };
struct Gemm { const bf16_t* A; const bf16_t* Bt; int M, N, K; };

struct StaticOrder {
    int nM, nN, nwg, G, c;
    __host__ __device__ void init(int M, int N, int G_, int c_) { nM = M / BM; nN = N / BM; nwg = nM * nN; G = G_; c = c_; }
    __host__ __device__ bool next(int i, Unit& u) const {
        const long L = (long)i * G + c; if (L >= nwg) return false;
        int wgid = (int)L; { const int q = nwg / NXCD, r = nwg % NXCD, xcd = wgid % NXCD, off = wgid / NXCD; wgid = (xcd < r ? xcd * (q + 1) : r * (q + 1) + (xcd - r) * q) + off; }
        const int nig = WGM * nN, gid = wgid / nig, fm = gid * WGM, gsz = (nM - fm) < WGM ? (nM - fm) : WGM;
        u.pm = fm + ((wgid % nig) % gsz); u.pn = (wgid % nig) / gsz; return true;
    }
    __device__ __forceinline__ void a_ready(const Unit&) const {}
    __device__ __forceinline__ void done(const Unit&) const {}
};

typedef float f32x2_ __attribute__((ext_vector_type(2))); typedef __bf16 bf16x2_ __attribute__((ext_vector_type(2)));
__device__ __forceinline__ void fx_add(unsigned long long* p, float v) { atomicAdd(p, (unsigned long long)(long long)(v * 16777216.0f)); }
__device__ __forceinline__ float fx_get(const unsigned long long* p) { return (float)(long long)(*p) * (1.0f / 16777216.0f); }
__device__ __forceinline__ unsigned cvt_pk_bf16(float lo, float hi) { const f32x2_ v = {lo, hi}; const bf16x2_ b = __builtin_convertvector(v, bf16x2_); return __builtin_bit_cast(unsigned, b); }


__device__ __forceinline__ float rowsum4(float x) {
    const unsigned ux = __builtin_bit_cast(unsigned, x);
    const auto a = __builtin_amdgcn_permlane16_swap(ux, ux, false, false);
    const float y = __builtin_bit_cast(float, (unsigned)a[0]) + __builtin_bit_cast(float, (unsigned)a[1]);
    const unsigned uy = __builtin_bit_cast(unsigned, y);
    const auto b = __builtin_amdgcn_permlane32_swap(uy, uy, false, false);
    return __builtin_bit_cast(float, (unsigned)b[0]) + __builtin_bit_cast(float, (unsigned)b[1]);
}
struct EpiZ {
    static constexpr bool PERM = true, AFTER_DRAIN = false;
    bf16_t* Z; int ldz; PG8_LAS unsigned char* slab0;     const PG8_LAS float* rst;     unsigned long long* st1; unsigned long long* st2; int st_lo, st_hi; int ug_tiles;
    __device__ __forceinline__ void operator()(const f32x4 (&acc)[2][2][4][2], const Unit& u, int ui, int wr, int wc, int fr, int fq) const {
        const int row0 = u.pm * BM + wr * 64 + fr, col0 = u.pn * BM + wc * 64 + 8 * fq;
        const bool dost = (u.pn >= st_lo) && (u.pn < st_hi);
        int ln_ = fr + 16 * fq; asm volatile("" : "+v"(ln_));
        PG8_LAS unsigned char* const slw = slab0 + (wr * 4 + wc) * 2304 + (ln_ & 15) * 144 + (ln_ >> 4) * 16;
        PG8_LAS unsigned char* const slr = slab0 + (wr * 4 + wc) * 2304 + (ln_ >> 3) * 144 + (ln_ & 7) * 16;
        const int drow = (ln_ >> 3) - (ln_ & 15), dcol = 8 * (ln_ & 7);
        float rs8[8];
#pragma unroll
        for (int g = 0; g < 8; ++g) rs8[g] = rst[ui * BM + wr * 64 + fr + (g >> 2) * HALF + (g & 3) * 16];
        if (u.pn < ug_tiles) {
#pragma unroll
            for (int ai = 0; ai < 2; ++ai)
#pragma unroll
                for (int m = 0; m < 4; ++m) {
                    const int row = row0 + ai * HALF + m * 16;
                    const float rs = rs8[4 * ai + m];
                    const f32x4 u0 = acc[ai][0][m][0] * rs, u1 = acc[ai][0][m][1] * rs, g0 = acc[ai][1][m][0] * rs, g1 = acc[ai][1][m][1] * rs;
                    f32x4 o0, o1;
#pragma unroll
                    for (int k = 0; k < 4; ++k) { o0[k] = u0[k] * g0[k] * __builtin_amdgcn_rcpf(1.0f + __builtin_amdgcn_exp2f(-1.4426950408889634f * g0[k])); o1[k] = u1[k] * g1[k] * __builtin_amdgcn_rcpf(1.0f + __builtin_amdgcn_exp2f(-1.4426950408889634f * g1[k])); }
                    u32x4 w; w.x = cvt_pk_bf16(o0[0], o0[1]); w.y = cvt_pk_bf16(o0[2], o0[3]); w.z = cvt_pk_bf16(o1[0], o1[1]); w.w = cvt_pk_bf16(o1[2], o1[3]);
                    *(u32x4*)(Z + (size_t)row * ldz + u.pn * 128 + wc * 32 + 8 * fq) = w;
                }
            return;
        }
        u32x4 wa, wb; float s1, s2;
#define EPZ_COMP(g) { const int ai_ = (g) >> 2, m_ = (g) & 3; const float rs = rs8[g]; \
            const f32x4 v0 = acc[ai_][0][m_][0] * rs, v1 = acc[ai_][0][m_][1] * rs, v2 = acc[ai_][1][m_][0] * rs, v3 = acc[ai_][1][m_][1] * rs; \
            wa.x = cvt_pk_bf16(v0[0], v0[1]); wa.y = cvt_pk_bf16(v0[2], v0[3]); wa.z = cvt_pk_bf16(v1[0], v1[1]); wa.w = cvt_pk_bf16(v1[2], v1[3]); \
            wb.x = cvt_pk_bf16(v2[0], v2[1]); wb.y = cvt_pk_bf16(v2[2], v2[3]); wb.z = cvt_pk_bf16(v3[0], v3[1]); wb.w = cvt_pk_bf16(v3[2], v3[3]); \
            if (dost) { \
                s1 = ((v0[0] + v0[1]) + (v0[2] + v0[3]) + (v1[0] + v1[1]) + (v1[2] + v1[3])) + ((v2[0] + v2[1]) + (v2[2] + v2[3]) + (v3[0] + v3[1]) + (v3[2] + v3[3])); \
                s2 = ((v0[0] * v0[0] + v0[1] * v0[1]) + (v0[2] * v0[2] + v0[3] * v0[3]) + (v1[0] * v1[0] + v1[1] * v1[1]) + (v1[2] * v1[2] + v1[3] * v1[3])) \
                   + ((v2[0] * v2[0] + v2[1] * v2[1]) + (v2[2] * v2[2] + v2[3] * v2[3]) + (v3[0] * v3[0] + v3[1] * v3[1]) + (v3[2] * v3[2] + v3[3] * v3[3])); } }
        s1 = 0.f; s2 = 0.f;
        EPZ_COMP(0)
#pragma unroll
        for (int g = 0; g < 8; ++g) {
            const int row = row0 + (g >> 2) * HALF + (g & 3) * 16;
            *(PG8_LAS u32x4*)(slw) = wa; *(PG8_LAS u32x4*)(slw + 64) = wb;
            float t1 = s1, t2 = s2;
            const u32x4 ra = *(const PG8_LAS u32x4*)(slr), rb = *(const PG8_LAS u32x4*)(slr + 1152);
            if (g < 7) EPZ_COMP(g + 1)
            bf16_t* zp = Z + (size_t)(row + drow) * ldz + (u.pn * BM + wc * 64 - 128 * ug_tiles) + dcol;
            *(u32x4*)zp = ra; *(u32x4*)(zp + (size_t)8 * ldz) = rb;
            if (dost) {
                t1 = rowsum4(t1); t2 = rowsum4(t2);
                if (fq == 0) { fx_add(st1 + row, t1); fx_add(st2 + row, t2); }
            }
        }
#undef EPZ_COMP
    }
};
struct EpiX {
    static constexpr bool PERM = true, AFTER_DRAIN = false;
    bf16_t* xb; unsigned long long* ssq_next; PG8_LAS unsigned char* slab0;
    __device__ __forceinline__ void operator()(const f32x4 (&acc)[2][2][4][2], const Unit& u, int ui, int wr, int wc, int fr, int fq) const {
        int ln_ = fr + 16 * fq; asm volatile("" : "+v"(ln_));
        PG8_LAS unsigned char* const slw = slab0 + (wr * 4 + wc) * 2304 + (ln_ & 15) * 144 + (ln_ >> 4) * 16;
        PG8_LAS unsigned char* const slr = slab0 + (wr * 4 + wc) * 2304 + (ln_ >> 3) * 144 + (ln_ & 7) * 16;
        const int drow = (ln_ >> 3) - (ln_ & 15), dcol = 8 * (ln_ & 7);
        const int row0 = u.pm * BM + wr * 64 + fr, col0 = u.pn * BM + wc * 64 + 8 * fq;
        u32x4 xa, xc, wa, wb; float s2;
#define EPX_LOAD(g) { const size_t off_ = (size_t)(row0 + ((g) >> 2) * HALF + ((g) & 3) * 16) * 2048 + col0; xa = *(const u32x4*)(xb + off_); xc = *(const u32x4*)(xb + off_ + 32); }
#define EPX_UP(w_) (f32x4){__uint_as_float((w_).x << 16), __uint_as_float((w_).x & 0xffff0000u), __uint_as_float((w_).y << 16), __uint_as_float((w_).y & 0xffff0000u)}
#define EPX_UQ(w_) (f32x4){__uint_as_float((w_).z << 16), __uint_as_float((w_).z & 0xffff0000u), __uint_as_float((w_).w << 16), __uint_as_float((w_).w & 0xffff0000u)}
#define EPX_COMP(g) { const int ai_ = (g) >> 2, m_ = (g) & 3; \
            const f32x4 v0 = acc[ai_][0][m_][0] + EPX_UP(xa), v1 = acc[ai_][0][m_][1] + EPX_UQ(xa), v2 = acc[ai_][1][m_][0] + EPX_UP(xc), v3 = acc[ai_][1][m_][1] + EPX_UQ(xc); \
            wa.x = cvt_pk_bf16(v0[0], v0[1]); wa.y = cvt_pk_bf16(v0[2], v0[3]); wa.z = cvt_pk_bf16(v1[0], v1[1]); wa.w = cvt_pk_bf16(v1[2], v1[3]); \
            wb.x = cvt_pk_bf16(v2[0], v2[1]); wb.y = cvt_pk_bf16(v2[2], v2[3]); wb.z = cvt_pk_bf16(v3[0], v3[1]); wb.w = cvt_pk_bf16(v3[2], v3[3]); \
              \
            const f32x4 r0 = EPX_UP(wa), r1 = EPX_UQ(wa), r2 = EPX_UP(wb), r3 = EPX_UQ(wb); \
            s2 = ((r0[0] * r0[0] + r0[1] * r0[1]) + (r0[2] * r0[2] + r0[3] * r0[3]) + (r1[0] * r1[0] + r1[1] * r1[1]) + (r1[2] * r1[2] + r1[3] * r1[3])) \
               + ((r2[0] * r2[0] + r2[1] * r2[1]) + (r2[2] * r2[2] + r2[3] * r2[3]) + (r3[0] * r3[0] + r3[1] * r3[1]) + (r3[2] * r3[2] + r3[3] * r3[3])); }
        EPX_LOAD(0)
        EPX_COMP(0)
        EPX_LOAD(1)
#pragma unroll
        for (int g = 0; g < 8; ++g) {
            const int row = row0 + (g >> 2) * HALF + (g & 3) * 16;
            *(PG8_LAS u32x4*)(slw) = wa; *(PG8_LAS u32x4*)(slw + 64) = wb;
            float t2 = s2;
            const u32x4 ra = *(const PG8_LAS u32x4*)(slr), rb = *(const PG8_LAS u32x4*)(slr + 1152);
            if (g < 7) EPX_COMP(g + 1)
            if (g < 6) EPX_LOAD(g + 2)
            bf16_t* zp = xb + (size_t)(row + drow) * 2048 + (u.pn * BM + wc * 64) + dcol;
            *(u32x4*)zp = ra; *(u32x4*)(zp + (size_t)8 * 2048) = rb;
            t2 = rowsum4(t2);
            if (fq == 0) fx_add(ssq_next + row, t2);
        }
#undef EPX_LOAD
#undef EPX_UP
#undef EPX_UQ
#undef EPX_COMP
    }
};
template <class Epi, class Sched, bool ALIGN_EPI = false, bool SP2 = false>
__device__ __forceinline__ void gemm_phase(PG8_LAS unsigned char* lds, const Gemm g, const Sched& S, const Epi& E, const int tid) {
    const int wid = __builtin_amdgcn_readfirstlane(tid >> 6), lane = tid & 63, wr = wid >> 2, wc = wid & 3, fr = lane & 15, fq = lane >> 4;
    const int K = g.K, nt = K / BK;
    unsigned voffA[2], voffB[2];
#pragma unroll
    for (int i = 0; i < 2; ++i) { int R, C; stage_rc(tid * 16 + i * 8192, R, C); const int Rb = Epi::PERM ? ((R >> 5) * 64 + perm32(R & 31)) : R;
        voffA[i] = (unsigned)(R * K + C) * 2u; voffB[i] = (unsigned)(Rb * K + C) * 2u; }
    const size_t kstep = (size_t)(BK * 2);
    const size_t hstep = (size_t)HALF * K * 2;
    const size_t tstep = 2 * hstep; const size_t hstepB = Epi::PERM ? (size_t)32 * K * 2 : hstep;
    const unsigned ldsw = (unsigned)wid * 1024u;
    const int aoff = lds_byte(wr * 64 + fr, fq * 8), boff = lds_byte(wc * 32 + fr, fq * 8);
#define PG8_SA(b, h) (((b) * 2 + (h)) * HTB)
#define PG8_SB(b, h) ((4 + (b) * 2 + (h)) * HTB)
#define PG8_STAGE(bufoff, gbase, voff) do { _Pragma("unroll") for (int _i = 0; _i < 2; ++_i) \
        __builtin_amdgcn_global_load_lds((const unsigned*)((const char*)(gbase) + (voff)[_i]), (PG8_LAS unsigned*)(lds + (bufoff) + ldsw + _i * 8192), 16, 0, 0); } while (0)
#define PG8_LDA(dst, b, h) do { _Pragma("unroll") for (int m = 0; m < 4; ++m) _Pragma("unroll") for (int k = 0; k < 2; ++k) dst[m][k] = *(const PG8_LAS bf16x8*)(lds + PG8_SA(b, h) + aoff + m * 2048 + k * 1024); } while (0)
#define PG8_LDB(dst, b, h) do { _Pragma("unroll") for (int n = 0; n < 2; ++n) _Pragma("unroll") for (int k = 0; k < 2; ++k) dst[n][k] = *(const PG8_LAS bf16x8*)(lds + PG8_SB(b, h) + boff + n * 2048 + k * 1024); } while (0)
#define PG8_MMA(ai, bj, At, Bt) do { __builtin_amdgcn_s_setprio(1); _Pragma("unroll") for (int m = 0; m < 4; ++m) _Pragma("unroll") for (int n = 0; n < 2; ++n) _Pragma("unroll") for (int k = 0; k < 2; ++k) \
        acc[ai][bj][m][n] = __builtin_amdgcn_mfma_f32_16x16x32_bf16(Bt[n][k], At[m][k], acc[ai][bj][m][n], 0, 0, 0); __builtin_amdgcn_s_setprio(0); } while (0)
#define PG8_WAIT_V(n) asm volatile("s_waitcnt vmcnt(" #n ")" ::: "memory")
#define PG8_WAIT_L(n) asm volatile("s_waitcnt lgkmcnt(" #n ")" ::: "memory")
#define PG8_BAR __builtin_amdgcn_s_barrier()
#define PG8_SCHED __builtin_amdgcn_sched_barrier(0)
    Unit cur, nxt; int ui = 0;
    if (!S.next(0, cur)) return;
    f32x4 acc[2][2][4][2];
#pragma unroll
    for (int a = 0; a < 2; ++a)
#pragma unroll
        for (int b = 0; b < 2; ++b)
#pragma unroll
            for (int m = 0; m < 4; ++m)
#pragma unroll
                for (int n = 0; n < 2; ++n) acc[a][b][m][n] = (f32x4){0.f, 0.f, 0.f, 0.f};
    bf16x8 At[4][2], B0[2][2], B1[2][2];
    const char* cA = (const char*)g.A + (size_t)cur.pm * tstep; const char* cB = (const char*)g.Bt + (size_t)cur.pn * tstep;
    S.a_ready(cur);
    if constexpr (SP2) {
        PG8_STAGE(PG8_SB(0, 0), cB, voffB); PG8_STAGE(PG8_SB(0, 1), cB + hstepB, voffB); PG8_STAGE(PG8_SA(0, 0), cA, voffA); PG8_STAGE(PG8_SA(0, 1), cA + hstep, voffA);
        if (wr == 1) PG8_BAR;
        PG8_WAIT_V(2); PG8_BAR;
        PG8_STAGE(PG8_SB(1, 0), cB + kstep, voffB); PG8_STAGE(PG8_SA(1, 0), cA + kstep, voffA); PG8_STAGE(PG8_SB(1, 1), cB + hstepB + kstep, voffB);
        PG8_WAIT_V(6); PG8_BAR;
    } else {
        PG8_STAGE(PG8_SB(0, 0), cB, voffB); PG8_STAGE(PG8_SA(0, 0), cA, voffA); PG8_STAGE(PG8_SB(0, 1), cB + hstepB, voffB); PG8_STAGE(PG8_SA(0, 1), cA + hstep, voffA);
        if (wr == 1) PG8_BAR;
        PG8_WAIT_V(4); PG8_BAR;
        PG8_STAGE(PG8_SB(1, 0), cB + kstep, voffB); PG8_STAGE(PG8_SA(1, 0), cA + kstep, voffA); PG8_STAGE(PG8_SB(1, 1), cB + hstepB + kstep, voffB);
        PG8_WAIT_V(6); PG8_BAR;
    }
    for (;;) {
        const bool has_next = S.next(ui + 1, nxt);
        const char* nA = has_next ? (const char*)g.A + (size_t)nxt.pm * tstep : cA; const char* nB = has_next ? (const char*)g.Bt + (size_t)nxt.pn * tstep : cB;
        for (int t = 0; t < nt; t += 2) {
            const bool last = (t == nt - 2);
            const char* a1 = cA + (size_t)(t + 1) * kstep;
            const char* a2 = last ? nA : cA + (size_t)(t + 2) * kstep; const char* b2 = last ? nB : cB + (size_t)(t + 2) * kstep;
            const char* a3 = a2 + kstep; const char* b3 = b2 + kstep;
            if (last && has_next) S.a_ready(nxt);
            if constexpr (SP2) {
            PG8_LDB(B0, 0, 0); PG8_LDB(B1, 0, 1); PG8_SCHED; PG8_LDA(At, 0, 0); PG8_STAGE(PG8_SA(1, 1), a1 + hstep, voffA);
            PG8_WAIT_V(8); PG8_WAIT_L(0); PG8_BAR; PG8_MMA(0, 0, At, B0); PG8_MMA(0, 1, At, B1); PG8_BAR; PG8_SCHED;
            PG8_LDA(At, 0, 1); PG8_STAGE(PG8_SB(0, 0), b2, voffB); PG8_STAGE(PG8_SB(0, 1), b2 + hstepB, voffB); PG8_STAGE(PG8_SA(0, 0), a2, voffA);
            PG8_WAIT_V(8); PG8_WAIT_L(0); PG8_BAR; PG8_MMA(1, 0, At, B0); PG8_MMA(1, 1, At, B1); PG8_BAR; PG8_SCHED;
            PG8_LDB(B0, 1, 0); PG8_LDB(B1, 1, 1); PG8_SCHED; PG8_LDA(At, 1, 0); PG8_STAGE(PG8_SA(0, 1), a2 + hstep, voffA);
            PG8_WAIT_V(8); PG8_WAIT_L(0); PG8_BAR; PG8_MMA(0, 0, At, B0); PG8_MMA(0, 1, At, B1); PG8_BAR; PG8_SCHED;
            PG8_LDA(At, 1, 1); PG8_STAGE(PG8_SB(1, 0), b3, voffB); PG8_STAGE(PG8_SB(1, 1), b3 + hstepB, voffB); PG8_STAGE(PG8_SA(1, 0), a3, voffA);
            PG8_WAIT_V(8); PG8_WAIT_L(0); PG8_BAR; PG8_MMA(1, 0, At, B0); PG8_MMA(1, 1, At, B1); PG8_BAR; PG8_SCHED;
            } else {
            PG8_LDB(B0, 0, 0); PG8_SCHED; PG8_LDA(At, 0, 0); PG8_STAGE(PG8_SA(1, 1), a1 + hstep, voffA);
            PG8_WAIT_L(8); PG8_BAR; PG8_WAIT_L(0); PG8_MMA(0, 0, At, B0); PG8_BAR; PG8_SCHED;
            PG8_LDB(B1, 0, 1); PG8_STAGE(PG8_SB(0, 0), b2, voffB);
            PG8_BAR; PG8_WAIT_L(0); PG8_MMA(0, 1, At, B1); PG8_BAR;
            PG8_LDA(At, 0, 1); PG8_STAGE(PG8_SA(0, 0), a2, voffA);
            PG8_BAR; PG8_WAIT_L(0); PG8_MMA(1, 0, At, B0); PG8_BAR; PG8_SCHED;
            PG8_STAGE(PG8_SB(0, 1), b2 + hstepB, voffB);
            PG8_WAIT_V(6); PG8_BAR; PG8_MMA(1, 1, At, B1); PG8_BAR;
            PG8_LDB(B0, 1, 0); PG8_SCHED; PG8_LDA(At, 1, 0); PG8_STAGE(PG8_SA(0, 1), a2 + hstep, voffA);
            PG8_WAIT_L(8); PG8_BAR; PG8_WAIT_L(0); PG8_MMA(0, 0, At, B0); PG8_BAR; PG8_SCHED;
            PG8_LDB(B1, 1, 1); PG8_STAGE(PG8_SB(1, 0), b3, voffB);
            PG8_BAR; PG8_WAIT_L(0); PG8_MMA(0, 1, At, B1); PG8_BAR;
            PG8_LDA(At, 1, 1); PG8_STAGE(PG8_SA(1, 0), a3, voffA);
            PG8_BAR; PG8_WAIT_L(0); PG8_MMA(1, 0, At, B0); PG8_BAR; PG8_SCHED;
            PG8_STAGE(PG8_SB(1, 1), b3 + hstepB, voffB);
            PG8_WAIT_V(6); PG8_BAR; PG8_MMA(1, 1, At, B1); PG8_BAR;
            }
        }
        if constexpr (ALIGN_EPI) { if (wr == 0) PG8_BAR; }
        if constexpr (!Epi::AFTER_DRAIN) { E(acc, cur, ui, wr, wc, fr, fq); S.done(cur); }
        if (!has_next) break;
#pragma unroll
        for (int a = 0; a < 2; ++a)
#pragma unroll
            for (int b = 0; b < 2; ++b)
#pragma unroll
                for (int m = 0; m < 4; ++m)
#pragma unroll
                    for (int n = 0; n < 2; ++n) acc[a][b][m][n] = (f32x4){0.f, 0.f, 0.f, 0.f};
        cur = nxt; cA = nA; cB = nB; ++ui;
        if constexpr (ALIGN_EPI) { if (wr == 1) PG8_BAR; }
    }
    PG8_WAIT_V(0);
    if constexpr (!ALIGN_EPI) { if (wr == 0) PG8_BAR; }
    PG8_BAR;
    if constexpr (Epi::AFTER_DRAIN) { E.fused(acc, cur, wr, wc, fr, fq, lds, wid, lane); S.done(cur); }
#undef PG8_SA
#undef PG8_SB
#undef PG8_STAGE
#undef PG8_LDA
#undef PG8_LDB
#undef PG8_MMA
#undef PG8_WAIT_V
#undef PG8_WAIT_L
#undef PG8_BAR
#undef PG8_SCHED
}
}

#ifndef PG8_SP2
#define PG8_SP2 true
#endif
#ifndef PG8_ALIGN
#define PG8_ALIGN true
#endif

constexpr int BATCH = 2, SEQ = 8192, DM = 2048, M = BATCH * SEQ;
constexpr int ZE = 6912, ZO = 6144, ECOLS = 6784, OCOLS = 6144;
constexpr int N_PHASES = 16;
constexpr unsigned long long PH_TYPE = 0x5431432143143210ull, PH_LAYER = 0x0333222211100000ull;
constexpr int ZC_XW = 4096, ZC_XA = 4160, ZC_E1 = 4224, ZC_E2 = 4256, ZC_Q = 4352, ZC_KB = 5376, ZC_VB = 5632, ZC_BG = 5888;
constexpr int ZO2 = 4096;

constexpr size_t MiB = 1u << 20;
constexpr size_t WS_CTL = 0, CTL_ZERO_BYTES = 1 * MiB;
constexpr size_t WS_STAT = 1 * MiB;
constexpr size_t WS_ROPE = 3 * MiB;
constexpr size_t WS_WEIN = 4 * MiB;
constexpr size_t WS_WOIN = 31 * MiB;
constexpr size_t WS_WEOUT = 55 * MiB;
constexpr size_t WS_WOOUT = 71 * MiB;
constexpr size_t WS_XB = 87 * MiB;
constexpr size_t WS_Y = 151 * MiB;
constexpr size_t WS_VF = 215 * MiB;
constexpr size_t WS_Z = 247 * MiB;
constexpr size_t WS_END = 463 * MiB;
constexpr int CW_BAR = 4096;

constexpr int RING_OFF = 0, RING_BYTES = 131072;
constexpr int RST_OFF = 131072, RST_UNITS = 8;
constexpr int LDSCTL_OFF = 162816, MISC_OFF = LDSCTL_OFF + 320;
constexpr int LDS_BYTES = 163840;
constexpr int NWAVES = 8;
#define GAS __attribute__((address_space(1)))
#define LAS __attribute__((address_space(3)))
typedef unsigned short bf16;
typedef unsigned v4u __attribute__((ext_vector_type(4)));
typedef float f32x4 __attribute__((ext_vector_type(4)));
typedef short bf16x8 __attribute__((ext_vector_type(8)));
typedef GAS unsigned gu32;
typedef GAS unsigned long long gu64;
#define RLX_AGENT __ATOMIC_RELAXED, __HIP_MEMORY_SCOPE_AGENT
#define LDS_WAIT() asm volatile("s_waitcnt lgkmcnt(0)" ::: "memory")
#define VM_WAIT() asm volatile("s_waitcnt vmcnt(0)" ::: "memory")
__device__ __forceinline__ unsigned long long rt() { return __builtin_amdgcn_s_memrealtime(); }
__device__ __forceinline__ unsigned f2bf(float f) { unsigned u = __builtin_bit_cast(unsigned, f); return (u + 0x7fffu + ((u >> 16) & 1u)) >> 16; }
__device__ __forceinline__ unsigned pk2(float lo, float hi) { return f2bf(lo) | (f2bf(hi) << 16); }

#define XB_TMO      128
#define XB_XCNT(j)  (256  + 64 * (j))
#define XB_XSUB(j)  (1280 + 64 * (j))
#define XB_XGEN(j)  (2304 + 64 * (j))
#define XB_TOP      3328
#define XB_TOPGEN   3392
#define XCD_BAR_WORDS 3456
#define XB_SPIN_CAP (1u << 18)

__device__ __forceinline__ unsigned xb_ld(unsigned* p)              { return __hip_atomic_load(p, __ATOMIC_RELAXED, __HIP_MEMORY_SCOPE_AGENT); }
__device__ __forceinline__ unsigned xb_add(unsigned* p, unsigned v) { return __hip_atomic_fetch_add(p, v, __ATOMIC_RELAXED, __HIP_MEMORY_SCOPE_AGENT); }
__device__ __forceinline__ unsigned xb_xcc_id() { return (unsigned)__builtin_amdgcn_s_getreg((3 << 11) | 20) & 0xFu; }
#define XB_SPIN(cond, bar) do { unsigned _sp = 0; while (cond) { __builtin_amdgcn_s_sleep(1); \
    if ((++_sp & 255u) == 0u) { if (xb_ld(&(bar)[XB_TMO])) break; if (_sp > XB_SPIN_CAP) { atomicAdd(&(bar)[XB_TMO], 1u); break; } } } } while (0)

struct XcdBarrier {
    unsigned* bar; unsigned x;
    volatile LAS unsigned* st;
};

__device__ __forceinline__ XcdBarrier xcd_barrier_post(unsigned* bar, volatile LAS unsigned* st) {
    XcdBarrier b; b.bar = bar; b.x = xb_xcc_id(); b.st = st;
    if (threadIdx.x == 0) (void)xb_add(&bar[XB_XCNT(b.x)], 1u);
    return b;
}
__device__ __forceinline__ void xcd_barrier_complete(unsigned* bar, unsigned x, unsigned& nloc, unsigned& nx) {
    const unsigned G = gridDim.x * gridDim.y * gridDim.z;
    unsigned sum, cnt, mine, sp = 0u;
    for (;;) {
        sum = 0u; cnt = 0u; mine = 0u;
#pragma unroll
        for (unsigned j = 0; j < 16; ++j) { const unsigned c = xb_ld(&bar[XB_XCNT(j)]); sum += c; cnt += (c > 0u) ? 1u : 0u; mine = (j == x) ? c : mine; }
        if (sum == G) break;
        __builtin_amdgcn_s_sleep(1);
        if ((++sp & 255u) == 0u) { if (xb_ld(&bar[XB_TMO])) break; if (sp > XB_SPIN_CAP) { atomicAdd(&bar[XB_TMO], 1u); break; } }
    }
    nloc = mine > 0u ? mine : 1u; nx = cnt > 0u ? cnt : 1u;
}

__device__ __forceinline__ void xcd_barrier(const XcdBarrier& b, const int tid) {
    asm volatile("s_waitcnt vmcnt(0)" ::: "memory");
    __syncthreads();
    if (tid == 0) {
        unsigned* bar = b.bar;
        __builtin_amdgcn_s_waitcnt(0);
        unsigned nloc = b.st[0], nx = b.st[1];
        if (nloc == 0u) { xcd_barrier_complete(bar, b.x, nloc, nx); b.st[0] = nloc; b.st[1] = nx; }
        const unsigned old = xb_add(&bar[XB_XSUB(b.x)], 1u);
        const unsigned gen = old / nloc;
        if (old + 1u == (gen + 1u) * nloc) {
            __builtin_amdgcn_fence(__ATOMIC_RELEASE, "agent");
            asm volatile("s_waitcnt vmcnt(0)" ::: "memory");
            const unsigned og = xb_add(&bar[XB_TOP], 1u);
            const unsigned tg = og / nx;
            if (og + 1u == (tg + 1u) * nx) xb_add(&bar[XB_TOPGEN], 1u);
            else XB_SPIN(xb_ld(&bar[XB_TOPGEN]) == tg, bar);
            __builtin_amdgcn_fence(__ATOMIC_ACQUIRE, "agent");
            xb_add(&bar[XB_XGEN(b.x)], 1u);
            asm volatile("s_waitcnt vmcnt(0)" ::: "memory");
        } else {
            XB_SPIN(xb_ld(&bar[XB_XGEN(b.x)]) == gen, bar);
            __builtin_amdgcn_fence(__ATOMIC_ACQUIRE, "agent");
            asm volatile("s_waitcnt vmcnt(0)" ::: "memory");
        }
    }
    __syncthreads();
}

typedef float f32x2 __attribute__((ext_vector_type(2)));
typedef unsigned u32x2 __attribute__((ext_vector_type(2)));
__device__ __forceinline__ float bflo(unsigned w) { return __uint_as_float(w << 16); }
__device__ __forceinline__ float bfhi(unsigned w) { return __uint_as_float(w & 0xffff0000u); }
__device__ __forceinline__ float bf2f(bf16 b) { return __uint_as_float((unsigned)b << 16); }
typedef __bf16 bf16x2_t __attribute__((ext_vector_type(2)));
__device__ __forceinline__ unsigned pkbf(float lo, float hi) { const f32x2 v = {lo, hi}; const bf16x2_t b = __builtin_convertvector(v, bf16x2_t); return __builtin_bit_cast(unsigned, b); }
template <int CTRL> __device__ __forceinline__ float dppf(float x) { return __int_as_float(__builtin_amdgcn_update_dpp(0, __float_as_int(x), CTRL, 0xF, 0xF, true)); }
#define DPP_XOR1 0xB1
#define DPP_XOR2 0x4E
#define DPP_HMIRROR 0x141
#define DPP_MIRROR 0x140
__device__ __forceinline__ float red4(float s) { s += dppf<DPP_XOR1>(s); s += dppf<DPP_XOR2>(s); return s; }
__device__ __forceinline__ float red8(float s) { s = red4(s); s += dppf<DPP_HMIRROR>(s); return s; }
__device__ __forceinline__ float red16(float s) { s = red8(s); s += dppf<DPP_MIRROR>(s); return s; }
__device__ __forceinline__ float max4(float s) { s = fmaxf(s, dppf<DPP_XOR1>(s)); s = fmaxf(s, dppf<DPP_XOR2>(s)); return s; }
__device__ __forceinline__ float wave_sum(float v) {
#pragma unroll
    for (int o = 1; o < 64; o <<= 1) v += __shfl_xor(v, o);
    return v;
}
__device__ __forceinline__ float fexp(float x) { return __builtin_amdgcn_exp2f(x * 1.4426950408889634f); }
__device__ __forceinline__ float flog(float x) { return __builtin_amdgcn_logf(x) * 0.6931471805599453f; }
__device__ __forceinline__ float sigmoidf_(float x) { return __builtin_amdgcn_rcpf(1.0f + fexp(-x)); }
__device__ __forceinline__ float siluf_(float x) { return x * __builtin_amdgcn_rcpf(1.0f + fexp(-x)); }

__device__ __forceinline__ int emap(int c) {
    if (c < 3072) { const int seg = c >> 10, cc = c & 1023; return (cc >> 6) * 256 + seg * 64 + (cc & 63); }
    if (c < 3136) return ZC_XW + (c - 3072);
    if (c < 3200) return ZC_XA + (c - 3136);
    if (c < 4224) { const int cc = c - 3200; return (cc >> 6) * 256 + 192 + (cc & 63); }
    if (c < 5248) return ZC_Q + (c - 4224);
    if (c < 5504) return ZC_KB + (c - 5248);
    if (c < 5760) return ZC_VB + (c - 5504);
    return ZC_BG + (c - 5760);
}
__device__ __forceinline__ int omap(int c) { if (c < 2048) return (c >> 7) * 256 + ((c >> 5) & 3) * 64 + (c & 31); if (c >= 4096) { const int ch = c - 4096; return (ch >> 7) * 256 + ((ch >> 5) & 3) * 64 + 32 + (ch & 31); } return 4096 + (c - 2048); }
__device__ __forceinline__ void conv_weight(const float* W, int Nsrc, const float* g, bf16* WT, int mapkind  , LAS float* scr, int gw, int NGW, int lane) {
    const int nblk = Nsrc / 64, nitems = 32 * nblk;
    const int lq = lane >> 4, l4 = 4 * (lane & 15);
    for (int it = gw; it < nitems; it += NGW) {
        const int kb = it / nblk, nb = it % nblk, k0 = 64 * kb, n0 = 64 * nb;
        const int drow = (mapkind == 1) ? emap(n0) : (mapkind == 2) ? omap(n0) : n0;
        const int drow_hi = (mapkind == 2) ? omap(n0 + 32) : drow + 32;
        f32x4 v[16];
#pragma unroll
        for (int i = 0; i < 16; ++i) v[i] = *(const f32x4*)(W + (size_t)(k0 + 4 * i + lq) * Nsrc + n0 + l4);
        if (g) {
            float gv[16];
#pragma unroll
            for (int i = 0; i < 16; ++i) gv[i] = g[k0 + 4 * i + lq];
            asm volatile("s_waitcnt vmcnt(0)" ::: "memory");
#pragma unroll
            for (int i = 0; i < 16; ++i) v[i] = v[i] * gv[i];
        }
#pragma unroll
        for (int i = 0; i < 16; ++i) { LAS float* d = scr + (4 * i + lq) * 65 + l4; d[0] = v[i][0]; d[1] = v[i][1]; d[2] = v[i][2]; d[3] = v[i][3]; }
        LDS_WAIT(); asm volatile("" ::: "memory");
        const int c = lane & 7;
#pragma unroll
        for (int j = 0; j < 8; ++j) { const int n = (lane >> 3) + 8 * j; const LAS float* s = scr + (8 * c) * 65 + n;
            v4u o; o.x = pkbf(s[0 * 65], s[1 * 65]); o.y = pkbf(s[2 * 65], s[3 * 65]); o.z = pkbf(s[4 * 65], s[5 * 65]); o.w = pkbf(s[6 * 65], s[7 * 65]);
            *(GAS v4u*)(WT + (size_t)((j < 4 ? drow : drow_hi) + (n & 31)) * 2048 + k0 + 8 * c) = o; }
        LDS_WAIT(); asm volatile("" ::: "memory");
    }
}
__device__ __forceinline__ void zero_rows(bf16* WT, int r0, int r1, int gtid, int NGT) {
    const size_t n16 = (size_t)(r1 - r0) * 2048 / 8;
    GAS v4u* p = (GAS v4u*)(WT + (size_t)r0 * 2048);
    for (size_t i = gtid; i < n16; i += NGT) p[i] = (v4u){0u, 0u, 0u, 0u};
}
__device__ __forceinline__ void conv_e12(const float* W  , const float* g  , const float* muv  , const float* v1  , bf16* WT, int gw, int NGW, int lane) {
    const int which = lane >> 5, j = lane & 31;
    for (int k = gw; k < 2048; k += NGW) {
        const float* wrow = W + (size_t)k * ECOLS + 2048;
        float acc = 0.f;
        for (int c0 = 0; c0 < 1024; c0 += 64) {
            const float wv = wrow[c0 + lane], mu = muv[c0 + lane];
            const float xa = wv * (1.0f - mu), xb = wv * mu;
#pragma unroll
            for (int i = 0; i < 64; ++i) {
                const float sa = __int_as_float(__builtin_amdgcn_readlane(__float_as_int(xa), i)), sb = __int_as_float(__builtin_amdgcn_readlane(__float_as_int(xb), i));
                acc += (which ? sb : sa) * v1[(c0 + i) * 32 + j];
            }
        }
        WT[(size_t)(ZC_E1 + lane) * 2048 + k] = (bf16)f2bf(acc * g[k]);
    }
}

struct RwkvP { const float *mu, *w0, *w2, *a0, *a2, *kk, *ka, *rk, *lnw, *lnb, *v0, *v2; int e; };

typedef short bf16x8 __attribute__((ext_vector_type(8)));
#define MFMA16(a, b, c) __builtin_amdgcn_mfma_f32_16x16x32_bf16((a), (b), (c), 0, 0, 0)
__device__ __forceinline__ bf16x8 ldfrag(const LAS bf16* p, int ld, int lane) { return *(const LAS bf16x8*)(p + (lane & 15) * ld + 8 * (lane >> 4)); }
__device__ __forceinline__ bf16x8 ldfrag16(const LAS bf16* p, int ld, int lane) { const bf16x8 z = {0, 0, 0, 0, 0, 0, 0, 0}; const bf16x8 f = *(const LAS bf16x8*)(p + (lane & 15) * ld + 8 * ((lane >> 4) & 1)); return (lane < 32) ? f : z; }
__device__ __forceinline__ void st_nat(LAS bf16* out, int ld, int m0, int lane, const f32x4 acc) { u32x2 w; w.x = pkbf(acc[0], acc[1]); w.y = pkbf(acc[2], acc[3]); *(LAS u32x2*)(out + (lane & 15) * ld + m0 + 4 * (lane >> 4)) = w; }

__device__ __forceinline__ bf16x8 ldfo(const LAS bf16* p, int off) { return *(const LAS bf16x8*)(p + off); }
__device__ __forceinline__ void st_no(LAS bf16* out, int off, const f32x4 acc) { u32x2 w; w.x = pkbf(acc[0], acc[1]); w.y = pkbf(acc[2], acc[3]); *(LAS u32x2*)(out + off) = w; }
constexpr int R2_S72 = 72, R2_S40 = 40;
constexpr int R2_W2T = 0, R2_A2T = 9216, R2_V2T = 18432, R2_SB0 = 23552, R2_SB1 = 32768, R2_TXW = 41984, R2_XA = 46592, R2_EE = 51200,
              R2_F68 = 68,
              R2_LCUM = 53760, R2_LAF = 62464, R2_LVF = 71168, R2_GC = 79872,
              R2_AH = 80128, R2_BH = 84736, R2_KH = 89344, R2_RH = 93952,
              R2_BGT = 98560, R2_KGT = 103936, R2_VT = 109312,
              R2_LAB = R2_TXW, R2_LAK = R2_TXW + 4096, R2_QRB = R2_TXW + 6656, R2_QRK = R2_TXW + 9216,
              R2_DM = R2_LCUM, R2_DTM = R2_LCUM + 2560, R2_MT = R2_LCUM + 5120,
              R2_TM = R2_LVF, R2_W1T = R2_LVF + 2560,
              R2_RHX = 117504, R2_UT = 122624, R2_BON = 127744, R2_UXT = 127872, R2_XB0 = 132992, R2_XB1 = 142208, R2_PAR = 151424, R2_END = 154496;
static_assert(R2_QRK + 2560 <= R2_LCUM && R2_MT + 2560 <= R2_LAF && R2_W1T + 5120 <= R2_GC && R2_VT + 5376 <= R2_RHX && R2_END <= 162816, "rwkv_v2 LDS map");
__device__ __forceinline__ int r2_sk(int r) { return r * R2_S40 + (r >> 2) * 8; }
typedef short r2_s16x4 __attribute__((ext_vector_type(4)));
__device__ __forceinline__ bf16x8 r2_trf(const LAS bf16* img, int tokA, int tokB, int c0, int n) {
    const LAS bf16* p = img + (n >> 2) * R2_S72 + c0 + 4 * (n & 3);
    const r2_s16x4 a = __builtin_bit_cast(r2_s16x4, __builtin_amdgcn_ds_read_tr16_b64_v4i16((LAS r2_s16x4*)(p + tokA * R2_S72)));
    const r2_s16x4 b = __builtin_bit_cast(r2_s16x4, __builtin_amdgcn_ds_read_tr16_b64_v4i16((LAS r2_s16x4*)(p + tokB * R2_S72)));
    return (bf16x8){a[0], a[1], a[2], a[3], b[0], b[1], b[2], b[3]};
}
__device__ __forceinline__ bf16x8 ldfrag_sk(const LAS bf16* base, int row0, int lane) { const int r = row0 + (lane & 15); return *(const LAS bf16x8*)(base + r2_sk(r) + 8 * (lane >> 4)); }

__device__ __forceinline__ void rwkv_v2(LAS unsigned char* lds, const RwkvP P, int b, int h, int seg, int mode, const bf16* Z, bf16* Y, bf16* VF, float* MG, unsigned char* CACHE, const int tid, const int wave) {
    LAS bf16* W2T = (LAS bf16*)(lds + R2_W2T); LAS bf16* A2T = (LAS bf16*)(lds + R2_A2T); LAS bf16* V2T = (LAS bf16*)(lds + R2_V2T);
    LAS bf16* TXW = (LAS bf16*)(lds + R2_TXW); LAS bf16* XAS = (LAS bf16*)(lds + R2_XA); LAS bf16* EES = (LAS bf16*)(lds + R2_EE);
    LAS float* LCUM = (LAS float*)(lds + R2_LCUM); LAS float* LAF = (LAS float*)(lds + R2_LAF); LAS float* LVF = (LAS float*)(lds + R2_LVF); LAS float* GC = (LAS float*)(lds + R2_GC);
    LAS float* YS = LAF;
    LAS bf16* AH = (LAS bf16*)(lds + R2_AH); LAS bf16* BH = (LAS bf16*)(lds + R2_BH); LAS bf16* KH = (LAS bf16*)(lds + R2_KH); LAS bf16* RH = (LAS bf16*)(lds + R2_RH);
    LAS bf16* BGT = (LAS bf16*)(lds + R2_BGT); LAS bf16* KGT = (LAS bf16*)(lds + R2_KGT); LAS bf16* VT = (LAS bf16*)(lds + R2_VT);
    LAS float* LAB = (LAS float*)(lds + R2_LAB); LAS bf16* LAK = (LAS bf16*)(lds + R2_LAK); LAS bf16* QRB = (LAS bf16*)(lds + R2_QRB); LAS bf16* QRK = (LAS bf16*)(lds + R2_QRK);
    LAS bf16* DM = (LAS bf16*)(lds + R2_DM); LAS bf16* DTM = (LAS bf16*)(lds + R2_DTM); LAS bf16* MT = (LAS bf16*)(lds + R2_MT); LAS bf16* TM = (LAS bf16*)(lds + R2_TM);
    LAS bf16* W1T = (LAS bf16*)(lds + R2_W1T); LAS bf16* RHX = (LAS bf16*)(lds + R2_RHX); LAS bf16* UT = (LAS bf16*)(lds + R2_UT); LAS float* BON = (LAS float*)(lds + R2_BON); LAS bf16* UXT = (LAS bf16*)(lds + R2_UXT);
    const int e = P.e, hc = h * 64, lane0 = tid & 63;
    u32x2 pf_r, pf_k, pf_v, pf_w, pf_a, pf_g, pf_pr = {0u, 0u}, pf_pk = {0u, 0u}, pf_pv = {0u, 0u}, pf_pw = {0u, 0u}, pf_pa = {0u, 0u}, pf_vf = {0u, 0u}, pf_e1 = {0u, 0u}, pf_e2 = {0u, 0u};
    {
        const int c4 = 4 * (lane0 & 15), cg = lane0 & 15; const int t = seg * 1024 + wave * 4 + (lane0 >> 4); const size_t m = (size_t)b * SEQ + t;
        const bf16* zn = Z + m * ZE; const bf16* zq = zn - ZE; const bool hp = t > 0;
        pf_r = *(const u32x2*)(zn + h * 256 + c4); pf_k = *(const u32x2*)(zn + h * 256 + 64 + c4); pf_v = *(const u32x2*)(zn + h * 256 + 128 + c4); pf_g = *(const u32x2*)(zn + h * 256 + 192 + c4);
        pf_w = *(const u32x2*)(zn + ZC_XW + c4); pf_a = *(const u32x2*)(zn + ZC_XA + c4);
        if (hp) { pf_pr = *(const u32x2*)(zq + h * 256 + c4); pf_pk = *(const u32x2*)(zq + h * 256 + 64 + c4); pf_pv = *(const u32x2*)(zq + h * 256 + 128 + c4); pf_pw = *(const u32x2*)(zq + ZC_XW + c4); pf_pa = *(const u32x2*)(zq + ZC_XA + c4); }
        if (e > 0) { pf_vf = *(const u32x2*)(VF + m * 1024 + hc + c4); if (cg < 8) { pf_e1 = *(const u32x2*)(zn + ZC_E1 + c4); if (hp) pf_e2 = *(const u32x2*)(zq + ZC_E2 + c4); } }
    }
#define R2_BAR() asm volatile("s_waitcnt lgkmcnt(0)\n\ts_barrier" ::: "memory")
#define R2_FOFF() const int F72 = n * R2_S72 + 8 * q, F40 = n * R2_S40 + 8 * q, FSK = r2_sk(n) + 8 * q, N72 = n * R2_S72 + 4 * q, N40 = n * R2_S40 + 4 * q; (void)F72; (void)F40; (void)FSK; (void)N72; (void)N40
#define R2_LANE() int lane = lane0; asm volatile("" : "+v"(lane)); const int q = lane >> 4, n = lane & 15, tk = wave * 4 + q, cg = n, c4 = 4 * n; (void)q; (void)n; (void)tk; (void)cg; (void)c4
    float w2r[8], a2r[8], v2r[4] = {0.f, 0.f, 0.f, 0.f}, parr[12];
#pragma unroll
    for (int i = 0; i < 8; ++i) { const int ii = tid + 512 * i, j = ii >> 6, c = ii & 63; w2r[i] = P.w2[(size_t)j * 1024 + hc + c]; a2r[i] = P.a2[(size_t)j * 1024 + hc + c]; }
    if (e > 0) {
#pragma unroll
        for (int i = 0; i < 4; ++i) { const int ii = tid + 512 * i, j = ii >> 6, c = ii & 63; v2r[i] = P.v2[(size_t)j * 1024 + hc + c]; } }
    { const int c = lane0;
      parr[0] = P.mu[hc + c]; parr[1] = P.mu[1024 + hc + c]; parr[2] = P.mu[2048 + hc + c]; parr[3] = P.mu[3072 + c]; parr[4] = P.mu[3136 + c];
      parr[5] = P.a0[hc + c]; parr[6] = P.kk[hc + c]; parr[7] = P.ka[hc + c]; parr[8] = P.rk[hc + c]; parr[9] = P.lnw[hc + c]; parr[10] = P.lnb[hc + c]; parr[11] = e > 0 ? P.v0[hc + c] : 0.f; }
    const f32x4 w0v = *(const f32x4*)(P.w0 + hc + 16 * (wave & 3) + 4 * (lane0 >> 4));
    f32x4 accS[2] = {{0.f, 0.f, 0.f, 0.f}, {0.f, 0.f, 0.f, 0.f}};
    f32x4 mr0 = {0.f, 0.f, 0.f, 0.f}, mr1 = mr0, gk[2] = {mr0, mr0};
    if (mode == 1 && seg > 0) {
        const float* MG0 = MG + (size_t)((b * 16 + h) * 8) * 8192; const int q_ = lane0 >> 4, n_ = lane0 & 15, ct_ = wave >> 1, vt0 = 2 * (wave & 1);
#pragma unroll
        for (int vi = 0; vi < 2; ++vi)
#pragma unroll
            for (int r = 0; r < 4; ++r) accS[vi][r] = MG0[4096 + (16 * (2 * (wave & 1) + vi) + 4 * q_ + r) * 64 + 16 * (wave >> 1) + n_];
        if (seg > 1) { const float* Mk = MG0 + 8192; mr0 = *(const f32x4*)(Mk + 8 * tid); mr1 = *(const f32x4*)(Mk + 8 * tid + 4);
#pragma unroll
            for (int vi = 0; vi < 2; ++vi)
#pragma unroll
                for (int r = 0; r < 4; ++r) gk[vi][r] = Mk[4096 + (16 * (2 * (wave & 1) + vi) + 4 * q_ + r) * 64 + 16 * (wave >> 1) + n_]; }
    }
#pragma unroll
    for (int i = 0; i < 8; ++i) { const int ii = tid + 512 * i, j = ii >> 6, c = ii & 63; W2T[c * R2_S72 + j] = (bf16)f2bf(w2r[i]); A2T[c * R2_S72 + j] = (bf16)f2bf(a2r[i]); }
    if (e > 0) {
#pragma unroll
        for (int i = 0; i < 4; ++i) { const int ii = tid + 512 * i, j = ii >> 6, c = ii & 63; V2T[c * R2_S40 + j] = (bf16)f2bf(v2r[i]); } }
    for (int i = tid; i < 2 * 9216 / 4; i += 512) ((LAS unsigned*)(lds + R2_SB0))[i] = 0u;
    LAS float* PAR = (LAS float*)(lds + R2_PAR);
    if (tid < 64) {
#pragma unroll
        for (int i = 0; i < 12; ++i) PAR[i * 64 + tid] = parr[i]; }
    f32x4 accX[2] = {{0.f, 0.f, 0.f, 0.f}, {0.f, 0.f, 0.f, 0.f}};
    float* MGu = MG + (size_t)((b * 16 + h) * 8 + seg) * 8192;
    unsigned char* CAu = CACHE + (size_t)((b * 16 + h) * 8 + seg) * 32 * 10240;
    LAS unsigned char* TMC = lds + R2_UXT;
    if (mode == 0) {
        for (int i = tid; i < 2 * 9216 / 4; i += 512) ((LAS unsigned*)(lds + R2_XB0))[i] = 0u;
        __syncthreads();
        if (tid < 64) ((LAS bf16*)(lds + R2_XB0))[tid * R2_S72 + tid] = (bf16)0x3F80;
        { const int q_ = lane0 >> 4, n_ = lane0 & 15, ct_ = wave >> 1;
#pragma unroll
          for (int vi = 0; vi < 2; ++vi)
#pragma unroll
              for (int r = 0; r < 4; ++r) accX[vi][r] = (16 * ct_ + 4 * q_ + r == 16 * (2 * (wave & 1) + vi) + n_) ? 1.f : 0.f; }
    } else if (seg > 0) {
        const float* MG0 = MG + (size_t)((b * 16 + h) * 8) * 8192;
        LAS bf16* MB = (LAS bf16*)(lds + R2_TXW);
        const int q_ = lane0 >> 4, n_ = lane0 & 15, ct_ = wave >> 1, vt0 = 2 * (wave & 1);
        int cur = (seg - 1) & 1;
        __syncthreads();
#pragma unroll
        for (int vi = 0; vi < 2; ++vi) st_nat((LAS bf16*)(lds + (cur ? R2_SB1 : R2_SB0)) + 16 * (wave >> 1) * R2_S72, R2_S72, 16 * (2 * (wave & 1) + vi), lane0, accS[vi]);
        for (int k = 1; k < seg; ++k) {
            *(LAS v4u*)(MB + (tid >> 3) * R2_S72 + 8 * (tid & 7)) = (v4u){pkbf(mr0[0], mr0[1]), pkbf(mr0[2], mr0[3]), pkbf(mr1[0], mr1[1]), pkbf(mr1[2], mr1[3])};
            f32x4 an[2] = {gk[0], gk[1]};
            if (k + 1 < seg) { const float* Mk = MG0 + (size_t)(k + 1) * 8192; mr0 = *(const f32x4*)(Mk + 8 * tid); mr1 = *(const f32x4*)(Mk + 8 * tid + 4);
#pragma unroll
                for (int vi = 0; vi < 2; ++vi)
#pragma unroll
                    for (int r = 0; r < 4; ++r) gk[vi][r] = Mk[4096 + (16 * (2 * (wave & 1) + vi) + 4 * q_ + r) * 64 + 16 * (wave >> 1) + n_]; }
            R2_BAR();
            const LAS bf16* Ti = (const LAS bf16*)(lds + (cur ? R2_SB1 : R2_SB0)); LAS bf16* To = (LAS bf16*)(lds + (cur ? R2_SB0 : R2_SB1));
#pragma unroll
            for (int vi = 0; vi < 2; ++vi) {
#pragma unroll
                for (int ks = 0; ks < 2; ++ks) an[vi] = MFMA16(ldfrag(MB + 16 * (2 * (wave & 1) + vi) * R2_S72 + 32 * ks, R2_S72, lane0), ldfrag(Ti + 16 * (wave >> 1) * R2_S72 + 32 * ks, R2_S72, lane0), an[vi]);
                accS[vi] = an[vi];
                st_nat(To + 16 * (wave >> 1) * R2_S72, R2_S72, 16 * (2 * (wave & 1) + vi), lane0, an[vi]);
            }
            cur ^= 1;
            R2_BAR();
        }
    }
    int sbuf = 0;
    const int tend = seg * 1024 + 1024;
    __syncthreads();
    for (int t0 = seg * 1024; t0 < seg * 1024 + 1024; t0 += 32) {
        const int t = t0 + wave * 4 + (lane0 >> 4); const size_t m = (size_t)b * SEQ + t;
        const bf16* zr = Z + m * ZE;
        LAS bf16* Scur = (LAS bf16*)(lds + (sbuf ? R2_SB1 : R2_SB0)); LAS bf16* Snxt = (LAS bf16*)(lds + (sbuf ? R2_SB0 : R2_SB1));
        LAS bf16* Xcur = (LAS bf16*)(lds + (sbuf ? R2_XB1 : R2_XB0)); LAS bf16* Xnxt = (LAS bf16*)(lds + (sbuf ? R2_XB0 : R2_XB1));
        float xr[4], xk[4], xv[4];
        u32x2 vfw, g2;
        v4u cq0 = {0u, 0u, 0u, 0u}, cq1 = {0u, 0u, 0u, 0u};
        if (mode == 1) { const unsigned char* cp = CAu + (size_t)((t0 >> 5) & 31) * 10240; cq0 = *(const v4u*)(cp + 16 * (wave * 64 + lane0)); if (wave < 2) cq1 = *(const v4u*)(cp + 16 * (512 + wave * 64 + lane0)); }
        {
            R2_LANE();
            const u32x2 r2 = pf_r, k2 = pf_k, v2 = pf_v, w2 = pf_w, a2 = pf_a, pr = pf_pr, pk = pf_pk, pv = pf_pv, pw = pf_pw, pa = pf_pa, e1 = pf_e1, e2 = pf_e2;
            vfw = pf_vf; g2 = pf_g;
            if (t0 + 32 < tend) {
                const bf16* zn = zr + (size_t)32 * ZE; const bf16* zq = zn - ZE;
                pf_r = *(const u32x2*)(zn + h * 256 + c4); pf_k = *(const u32x2*)(zn + h * 256 + 64 + c4); pf_v = *(const u32x2*)(zn + h * 256 + 128 + c4); pf_g = *(const u32x2*)(zn + h * 256 + 192 + c4);
                pf_w = *(const u32x2*)(zn + ZC_XW + c4); pf_a = *(const u32x2*)(zn + ZC_XA + c4);
                pf_pr = *(const u32x2*)(zq + h * 256 + c4); pf_pk = *(const u32x2*)(zq + h * 256 + 64 + c4); pf_pv = *(const u32x2*)(zq + h * 256 + 128 + c4); pf_pw = *(const u32x2*)(zq + ZC_XW + c4); pf_pa = *(const u32x2*)(zq + ZC_XA + c4);
                if (e > 0) { pf_vf = *(const u32x2*)(VF + (m + 32) * 1024 + hc + c4); if (cg < 8) { pf_e1 = *(const u32x2*)(zn + ZC_E1 + c4); pf_e2 = *(const u32x2*)(zq + ZC_E2 + c4); } }
            }
            const f32x4 mur = *(const LAS f32x4*)(PAR + 0 * 64 + c4), muk = *(const LAS f32x4*)(PAR + 1 * 64 + c4), muv = *(const LAS f32x4*)(PAR + 2 * 64 + c4), muw = *(const LAS f32x4*)(PAR + 3 * 64 + c4), mua = *(const LAS f32x4*)(PAR + 4 * 64 + c4);
#define R2_UP(w) ((f32x2){bflo(w), bfhi(w)})
            float tw[4], ta[4];
            {
                const unsigned cu[2][5] = {{r2.x, k2.x, v2.x, w2.x, a2.x}, {r2.y, k2.y, v2.y, w2.y, a2.y}}, pu[2][5] = {{pr.x, pk.x, pv.x, pw.x, pa.x}, {pr.y, pk.y, pv.y, pw.y, pa.y}};
#pragma unroll
                for (int h2 = 0; h2 < 2; ++h2) {
                    const f32x2 m_r = {mur[2 * h2], mur[2 * h2 + 1]}, m_k = {muk[2 * h2], muk[2 * h2 + 1]}, m_v = {muv[2 * h2], muv[2 * h2 + 1]}, m_w = {muw[2 * h2], muw[2 * h2 + 1]}, m_a = {mua[2 * h2], mua[2 * h2 + 1]};
                    const f32x2 c_r = R2_UP(cu[h2][0]), c_k = R2_UP(cu[h2][1]), c_v = R2_UP(cu[h2][2]), c_w = R2_UP(cu[h2][3]), c_a = R2_UP(cu[h2][4]);
                    const f32x2 x_r = c_r + (R2_UP(pu[h2][0]) - c_r) * m_r, x_k = c_k + (R2_UP(pu[h2][1]) - c_k) * m_k, x_v = c_v + (R2_UP(pu[h2][2]) - c_v) * m_v;
                    const f32x2 x_w = c_w + (R2_UP(pu[h2][3]) - c_w) * m_w, x_a = c_a + (R2_UP(pu[h2][4]) - c_a) * m_a;
                    xr[2 * h2] = x_r.x; xr[2 * h2 + 1] = x_r.y; xk[2 * h2] = x_k.x; xk[2 * h2 + 1] = x_k.y; xv[2 * h2] = x_v.x; xv[2 * h2 + 1] = x_v.y;
                    const f32x2 t2 = x_w * (f32x2){2.8853900817779268f, 2.8853900817779268f}; f32x2 ex = {__builtin_amdgcn_exp2f(t2.x), __builtin_amdgcn_exp2f(t2.y)}; ex = ex + (f32x2){1.f, 1.f};
                    const f32x2 rc = {__builtin_amdgcn_rcpf(ex.x), __builtin_amdgcn_rcpf(ex.y)}; const f32x2 th = (f32x2){1.f, 1.f} - rc * (f32x2){2.f, 2.f};
                    tw[2 * h2] = th.x; tw[2 * h2 + 1] = th.y; ta[2 * h2] = x_a.x; ta[2 * h2 + 1] = x_a.y;
                }
            }
#undef R2_UP
            *(LAS u32x2*)(TXW + tk * R2_S72 + c4) = (u32x2){pkbf(tw[0], tw[1]), pkbf(tw[2], tw[3])};
            *(LAS u32x2*)(XAS + tk * R2_S72 + c4) = (u32x2){pkbf(ta[0], ta[1]), pkbf(ta[2], ta[3])};
            if (e > 0 && cg < 8) {
                *(LAS u32x2*)(EES + tk * R2_S40 + c4) = (u32x2){pkbf(bflo(e1.x) + bflo(e2.x), bfhi(e1.x) + bfhi(e2.x)), pkbf(bflo(e1.y) + bflo(e2.y), bfhi(e1.y) + bfhi(e2.y))};
            }
        }
        R2_BAR();
        if (wave < 4) {
            R2_LANE();
            const int ct = wave;
            f32x4 aw[2];
#pragma unroll
            for (int tt = 0; tt < 2; ++tt) {
                aw[tt] = (f32x4){0.f, 0.f, 0.f, 0.f};
#pragma unroll
                for (int ks = 0; ks < 2; ++ks) aw[tt] = MFMA16(ldfrag(W2T + 16 * ct * R2_S72 + 32 * ks, R2_S72, lane), ldfrag(TXW + 16 * tt * R2_S72 + 32 * ks, R2_S72, lane), aw[tt]);
            }
            f32x4 pc[2];
#pragma unroll
            for (int tt = 0; tt < 2; ++tt)
#pragma unroll
                for (int r = 0; r < 4; ++r) {
                    const float x = w0v[r] + aw[tt][r]; float v = -0.6065306597126334f * __builtin_amdgcn_rcpf(1.0f + fexp(-x));
                    v += dppf<0x111>(v); v += dppf<0x112>(v); v += dppf<0x114>(v); v += dppf<0x118>(v);
                    pc[tt][r] = v;
                }
#pragma unroll
            for (int r = 0; r < 4; ++r) pc[1][r] += dppf<0x15F>(pc[0][r]);
#pragma unroll
            for (int tt = 0; tt < 2; ++tt) *(LAS f32x4*)(LCUM + (16 * tt + n) * R2_F68 + 16 * ct + 4 * q) = pc[tt];
        } else {
            R2_LANE();
            const int ct = wave - 4;
#pragma unroll
            for (int tt = 0; tt < 2; ++tt) {
                f32x4 aa = {0.f, 0.f, 0.f, 0.f}, av = {0.f, 0.f, 0.f, 0.f};
#pragma unroll
                for (int ks = 0; ks < 2; ++ks) aa = MFMA16(ldfrag(A2T + 16 * ct * R2_S72 + 32 * ks, R2_S72, lane), ldfrag(XAS + 16 * tt * R2_S72 + 32 * ks, R2_S72, lane), aa);
                if (e > 0) av = MFMA16(ldfrag(V2T + 16 * ct * R2_S40, R2_S40, lane), ldfrag(EES + 16 * tt * R2_S40, R2_S40, lane), av);
                *(LAS f32x4*)(LAF + (16 * tt + n) * R2_F68 + 16 * ct + 4 * q) = aa; *(LAS f32x4*)(LVF + (16 * tt + n) * R2_F68 + 16 * ct + 4 * q) = av;
            }
        }
        R2_BAR();
        float vv[4];
        {
            R2_LANE();
            const f32x4 la = *(const LAS f32x4*)(LAF + tk * R2_F68 + c4), lv = *(const LAS f32x4*)(LVF + tk * R2_F68 + c4);
            const f32x4 Lc = *(const LAS f32x4*)(LCUM + tk * R2_F68 + c4), Le = *(const LAS f32x4*)(LCUM + 31 * R2_F68 + c4);
            f32x4 Lp = {0.f, 0.f, 0.f, 0.f}; if (tk > 0) Lp = *(const LAS f32x4*)(LCUM + (tk - 1) * R2_F68 + c4);
            const float vf[4] = {bflo(vfw.x), bfhi(vfw.x), bflo(vfw.y), bfhi(vfw.y)};
            const f32x4 a0c = *(const LAS f32x4*)(PAR + 5 * 64 + c4), kkc = *(const LAS f32x4*)(PAR + 6 * 64 + c4), kac = *(const LAS f32x4*)(PAR + 7 * 64 + c4), rkc = *(const LAS f32x4*)(PAR + 8 * 64 + c4), v0c = *(const LAS f32x4*)(PAR + 11 * 64 + c4);
            const f32x2 NL2E = {-1.4426950408889634f, -1.4426950408889634f}, L2E = {1.4426950408889634f, 1.4426950408889634f}, ONE = {1.f, 1.f};
            f32x2 kkr[2], kn[2], alr[2], vv2[2], xr2[2], ss2 = {0.f, 0.f}, bon2 = {0.f, 0.f};
#pragma unroll
            for (int h2 = 0; h2 < 2; ++h2) {
                const f32x2 xk2 = {xk[2 * h2], xk[2 * h2 + 1]}, xv2 = {xv[2 * h2], xv[2 * h2 + 1]}; xr2[h2] = (f32x2){xr[2 * h2], xr[2 * h2 + 1]};
                const f32x2 a0_ = {a0c[2 * h2], a0c[2 * h2 + 1]}, la_ = {la[2 * h2], la[2 * h2 + 1]}, kkc_ = {kkc[2 * h2], kkc[2 * h2 + 1]}, kac_ = {kac[2 * h2], kac[2 * h2 + 1]}, rkc_ = {rkc[2 * h2], rkc[2 * h2 + 1]};
                const f32x2 ta = (a0_ + la_) * NL2E; f32x2 ea = {__builtin_amdgcn_exp2f(ta.x), __builtin_amdgcn_exp2f(ta.y)}; ea = ea + ONE;
                alr[h2] = (f32x2){__builtin_amdgcn_rcpf(ea.x), __builtin_amdgcn_rcpf(ea.y)};
                if (e > 0) {
                    const f32x2 v0_ = {v0c[2 * h2], v0c[2 * h2 + 1]}, lv_ = {lv[2 * h2], lv[2 * h2 + 1]}, vf_ = {vf[2 * h2], vf[2 * h2 + 1]};
                    const f32x2 tv = (v0_ + lv_) * NL2E; f32x2 ev = {__builtin_amdgcn_exp2f(tv.x), __builtin_amdgcn_exp2f(tv.y)}; ev = ev + ONE;
                    const f32x2 sg = {__builtin_amdgcn_rcpf(ev.x), __builtin_amdgcn_rcpf(ev.y)};
                    vv2[h2] = xv2 + (vf_ - xv2) * sg;
                } else vv2[h2] = xv2;
                kkr[h2] = xk2 * kkc_; ss2 = ss2 + kkr[h2] * kkr[h2];
                kn[h2] = xk2 * (ONE + (alr[h2] - ONE) * kac_);
                bon2 = bon2 + xr2[h2] * kn[h2] * rkc_;
                vv[2 * h2] = vv2[h2].x; vv[2 * h2 + 1] = vv2[h2].y;
            }
            if (e == 0 && mode == 1) { u32x2 o; o.x = pkbf(xv[0], xv[1]); o.y = pkbf(xv[2], xv[3]); *(u32x2*)(VF + m * 1024 + hc + c4) = o; }
            const float ss = red16(ss2.x + ss2.y), bon = red16(bon2.x + bon2.y);
            const float inv = __builtin_amdgcn_rsqf(ss + 1e-12f);
            unsigned wah[2], wbh[2], wkh[2], wrh[2], wbgh[2], wkgh[2], wvvh[2];
#pragma unroll
            for (int h2 = 0; h2 < 2; ++h2) {
                const f32x2 Lc_ = {Lc[2 * h2], Lc[2 * h2 + 1]}, Lp_ = {Lp[2 * h2], Lp[2 * h2 + 1]}, Le_ = {Le[2 * h2], Le[2 * h2 + 1]};
                const f32x2 k1 = kkr[h2] * inv, bv = k1 * alr[h2];
                const f32x2 tL = Lc_ * L2E, tP = Lp_ * L2E, tE = Le_ * L2E;
                const f32x2 eL = {__builtin_amdgcn_exp2f(tL.x), __builtin_amdgcn_exp2f(tL.y)}, eLp = {__builtin_amdgcn_exp2f(tP.x), __builtin_amdgcn_exp2f(tP.y)}, eE = {__builtin_amdgcn_exp2f(tE.x), __builtin_amdgcn_exp2f(tE.y)};
                const f32x2 eN = {__builtin_amdgcn_rcpf(eL.x), __builtin_amdgcn_rcpf(eL.y)}, eD = eE * eN;
                const f32x2 ah = -(k1 * eLp), rh = xr2[h2] * eL, bg = bv * eD, kg = kn[h2] * eD;
                wah[h2] = pkbf(ah.x, ah.y); wrh[h2] = pkbf(rh.x, rh.y);
                if (mode == 0) { const f32x2 bh = bv * eN, kh = kn[h2] * eN; wbh[h2] = pkbf(bh.x, bh.y); wkh[h2] = pkbf(kh.x, kh.y); }
                const unsigned wbg = pkbf(bg.x, bg.y), wkg = pkbf(kg.x, kg.y), wvv = pkbf(vv2[h2].x, vv2[h2].y);
                wbgh[h2] = wbg; wkgh[h2] = wkg; wvvh[h2] = wvv;
                if (tk == 31) { GC[c4 + 2 * h2] = eL.x; GC[c4 + 2 * h2 + 1] = eL.y; }
            }
            *(LAS u32x2*)(AH + tk * R2_S72 + c4) = (u32x2){wah[0], wah[1]};
            *(LAS u32x2*)(BGT + tk * R2_S72 + c4) = (u32x2){wbgh[0], wbgh[1]}; *(LAS u32x2*)(KGT + tk * R2_S72 + c4) = (u32x2){wkgh[0], wkgh[1]}; *(LAS u32x2*)(VT + tk * R2_S72 + c4) = (u32x2){wvvh[0], wvvh[1]};
            *(LAS u32x2*)(RH + tk * R2_S72 + c4) = (u32x2){wrh[0], wrh[1]};
            if (mode == 0) { *(LAS u32x2*)(BH + tk * R2_S72 + c4) = (u32x2){wbh[0], wbh[1]}; *(LAS u32x2*)(KH + tk * R2_S72 + c4) = (u32x2){wkh[0], wkh[1]}; }
            if (cg == 0) BON[tk] = bon;
            if (mode == 1) { const int p = wave * 64 + lane; if (p < 480) *(LAS v4u*)(lds + R2_LAK + 16 * p) = cq0; else *(LAS v4u*)(TMC + 16 * (p - 480)) = cq0; if (wave < 2) *(LAS v4u*)(TMC + 16 * (32 + p)) = cq1; }
        }
        R2_BAR();
        if (mode == 0) {
            R2_LANE(); R2_FOFF();
            const int p = wave >> 1, half = wave & 1;
            const LAS bf16* As = (p & 1) ? KH : BH; const LAS bf16* Bs = (p < 2) ? AH : RH;
#pragma unroll
            for (int ti = 0; ti < 2; ++ti) {
                if (half == 1 && ti == 1) break;
                const int mt = (half == 1) ? 0 : ti, nt = (half == 1) ? 1 : ti;
                f32x4 acc = {0.f, 0.f, 0.f, 0.f};
                { const bf16x8 a0 = ldfo(As + 16 * mt * R2_S72, F72), a1 = ldfo(As + 16 * mt * R2_S72 + 32, F72), b0 = ldfo(Bs + 16 * nt * R2_S72, F72), b1 = ldfo(Bs + 16 * nt * R2_S72 + 32, F72);
                  acc = MFMA16(a0, b0, acc); acc = MFMA16(a1, b1, acc); }
                const int nn = 16 * nt + n, m0 = 16 * mt + 4 * q;
#pragma unroll
                for (int r = 0; r < 4; ++r) { const bool keep = (p < 2) ? (m0 + r < nn) : (m0 + r <= nn); acc[r] = keep ? acc[r] : 0.f; }
                if (p == 0) *(LAS f32x4*)(LAB + nn * 32 + m0) = acc;
                else st_no(((p == 1) ? LAK : (p == 2) ? QRB : QRK) + 16 * nt * R2_S40 + 16 * mt, N40, acc);
            }
            if (half == 1 && p > 0) {
                LAS bf16* O = (p == 1) ? LAK : (p == 2) ? QRB : QRK;
                *(LAS u32x2*)(O + n * R2_S40 + 16 + 4 * q) = (u32x2){0u, 0u};
            }
        }
        if (mode == 0) R2_BAR();
        if (mode == 1) {
            R2_LANE(); R2_FOFF();
            const int vt = wave >> 1, hf = wave & 1;
#define R2_PK2(x0, x1) __builtin_bit_cast(bf16x8, (v4u){pkbf((x0)[0], (x0)[1]), pkbf((x0)[2], (x0)[3]), pkbf((x1)[0], (x1)[1]), pkbf((x1)[2], (x1)[3])})
#define R2_LDP(dst, p) { const u32x2 lo_ = *(const LAS u32x2*)((p) + 4 * q), hi_ = *(const LAS u32x2*)((p) + 16 + 4 * q); dst = __builtin_bit_cast(bf16x8, (v4u){lo_.x, lo_.y, hi_.x, hi_.y}); }
            const bf16x8 sb0 = ldfo(Scur + 16 * vt * R2_S72, F72), sb1 = ldfo(Scur + 16 * vt * R2_S72 + 32, F72), vb = r2_trf(VT, 8 * q, 8 * q + 4, 16 * vt, n);
            const bf16x8 a00 = ldfo(AH, F72), a01 = ldfo(AH + 32, F72), a10 = ldfo(AH + 16 * R2_S72, F72), a11 = ldfo(AH + 16 * R2_S72 + 32, F72), l0 = ldfo(LAK, F40), l1 = ldfo(LAK + 16 * R2_S40, F40);
            bf16x8 t0, t1, qb;
            R2_LDP(t0, (const LAS bf16*)TMC + n * R2_S40); R2_LDP(t1, (const LAS bf16*)TMC + (16 + n) * R2_S40);
            R2_LDP(qb, QRB + (16 * hf + n) * R2_S40);
            const bf16x8 bg0 = r2_trf(BGT, 4 * q, 16 + 4 * q, 32 * hf, n), bg1 = r2_trf(BGT, 4 * q, 16 + 4 * q, 32 * hf + 16, n);
            const bf16x8 rh0 = ldfo(RH + 16 * hf * R2_S72, F72), rh1 = ldfo(RH + 16 * hf * R2_S72 + 32, F72), qk = ldfo(QRK + 16 * hf * R2_S40, F40);
            const bf16x8 kg0 = r2_trf(KGT, 8 * q, 8 * q + 4, 32 * hf, n), kg1 = r2_trf(KGT, 8 * q, 8 * q + 4, 32 * hf + 16, n);
            const f32x4 g40 = *(const LAS f32x4*)(GC + 32 * hf + 4 * q), g41 = *(const LAS f32x4*)(GC + 32 * hf + 16 + 4 * q);
            const f32x4 z4 = {0.f, 0.f, 0.f, 0.f};
            f32x4 r0 = z4, r1 = z4;
            r0 = MFMA16(a00, sb0, r0); r1 = MFMA16(a10, sb0, r1); r0 = MFMA16(a01, sb1, r0); r1 = MFMA16(a11, sb1, r1); r0 = MFMA16(l0, vb, r0); r1 = MFMA16(l1, vb, r1);
            f32x4 ay = z4; ay = MFMA16(sb0, rh0, ay); ay = MFMA16(sb1, rh1, ay); ay = MFMA16(vb, qk, ay);
            f32x4 s0 = accS[0] * g40, s1 = accS[1] * g41;
            s0 = MFMA16(kg0, vb, s0); s1 = MFMA16(kg1, vb, s1);
            const bf16x8 rb = R2_PK2(r0, r1);
            f32x4 u0 = z4, u1 = z4; u0 = MFMA16(t0, rb, u0); u1 = MFMA16(t1, rb, u1);
            const bf16x8 ub = R2_PK2(u0, u1);
            ay = MFMA16(ub, qb, ay); s0 = MFMA16(bg0, ub, s0); s1 = MFMA16(bg1, ub, s1);
            *(LAS f32x4*)(YS + (16 * hf + n) * R2_F68 + 16 * vt + 4 * q) = ay;
            accS[0] = s0; accS[1] = s1;
            st_no(Snxt + 16 * vt * R2_S72 + 32 * hf, N72, s0); st_no(Snxt + 16 * vt * R2_S72 + 32 * hf + 16, N72, s1);
#undef R2_PK2
#undef R2_LDP
            R2_BAR();
        } else {
        if (wave == 0 && mode == 0) {
            R2_LANE();
            const int blk = (lane >> 4) & 1; float d[16];
            {
                f32x4 le[2][2], lt[2];
                d[0] = (n == 0) ? 1.f : 0.f;
                le[1][0] = *(const LAS f32x4*)(LAB + (16 * blk + 1) * 32 + 16 * blk);
#pragma unroll
                for (int i = 1; i < 16; ++i) {
                    if (i > 8) lt[0] = *(const LAS f32x4*)(LAB + (16 * blk + i) * 32 + 16 * blk + 8);
                    if (i > 12) lt[1] = *(const LAS f32x4*)(LAB + (16 * blk + i) * 32 + 16 * blk + 12);
                    if (i + 1 < 16) { le[(i + 1) & 1][0] = *(const LAS f32x4*)(LAB + (16 * blk + i + 1) * 32 + 16 * blk); if (i + 1 > 4) le[(i + 1) & 1][1] = *(const LAS f32x4*)(LAB + (16 * blk + i + 1) * 32 + 16 * blk + 4); }
                    float acc = (i == n) ? 1.f : 0.f;
#pragma unroll
                    for (int j = 0; j < 8; ++j) if (j < i) acc += le[i & 1][j >> 2][j & 3] * d[j];
#pragma unroll
                    for (int j = 8; j < 16; ++j) if (j < i) acc += lt[(j - 8) >> 2][j & 3] * d[j];
                    d[i] = acc;
                    asm volatile("" ::: "memory");
                }
#pragma unroll
                for (int i = 0; i < 16; i += 2) { const unsigned w = pkbf(d[i], d[i + 1]); const bf16 lo = (bf16)(w & 0xffffu), hi = (bf16)(w >> 16);
                    DM[(16 * blk + i) * R2_S40 + n] = lo; TM[(16 * blk + i) * R2_S40 + 16 * blk + n] = lo; DM[(16 * blk + i + 1) * R2_S40 + n] = hi; TM[(16 * blk + i + 1) * R2_S40 + 16 * blk + n] = hi; }
#pragma unroll
                for (int i4 = 0; i4 < 4; ++i4) *(LAS u32x2*)(DTM + (16 * blk + n) * R2_S40 + 4 * i4) = (u32x2){pkbf(d[4 * i4], d[4 * i4 + 1]), pkbf(d[4 * i4 + 2], d[4 * i4 + 3])};
            }
            asm volatile("s_waitcnt lgkmcnt(0)" ::: "memory");
            bf16x8 afr;
            { const int q1 = q & 1; const f32x4 l0 = *(const LAS f32x4*)(LAB + (16 + n) * 32 + 8 * q1), l1 = *(const LAS f32x4*)(LAB + (16 + n) * 32 + 8 * q1 + 4);
                v4u w = {pkbf(l0[0], l0[1]), pkbf(l0[2], l0[3]), pkbf(l1[0], l1[1]), pkbf(l1[2], l1[3])}; if (q >= 2) w = (v4u){0u, 0u, 0u, 0u}; afr = __builtin_bit_cast(bf16x8, w); }
            f32x4 mac = {0.f, 0.f, 0.f, 0.f};
            mac = MFMA16(afr, ldfrag16(DTM, R2_S40, lane), mac);
            st_nat(MT, R2_S40, 0, lane, mac);
            asm volatile("s_waitcnt lgkmcnt(0)" ::: "memory");
            f32x4 tac = {0.f, 0.f, 0.f, 0.f};
            tac = MFMA16(ldfrag16(DM + 16 * R2_S40, R2_S40, lane), ldfrag16(MT, R2_S40, lane), tac);
            { const unsigned w0 = pkbf(tac[0], tac[1]), w1 = pkbf(tac[2], tac[3]); TM[(16 + 4 * q + 0) * R2_S40 + n] = (bf16)(w0 & 0xffffu); TM[(16 + 4 * q + 1) * R2_S40 + n] = (bf16)(w0 >> 16); TM[(16 + 4 * q + 2) * R2_S40 + n] = (bf16)(w1 & 0xffffu); TM[(16 + 4 * q + 3) * R2_S40 + n] = (bf16)(w1 >> 16); }
        } else if (wave == 1 && mode == 0) {
            R2_LANE();
            *(LAS u32x2*)(TM + (lane >> 2) * R2_S40 + 16 + 4 * (lane & 3)) = (u32x2){0u, 0u};
        } else if (wave >= 4) {
            R2_LANE(); R2_FOFF();
            const int vt = wave - 4;
            const bf16x8 sb0 = ldfo(Scur + 16 * vt * R2_S72, F72), sb1 = ldfo(Scur + 16 * vt * R2_S72 + 32, F72), vb = r2_trf(VT, 8 * q, 8 * q + 4, 16 * vt, n);
            const bf16x8 a00 = ldfo(AH, F72), a01 = ldfo(AH + 32, F72), a10 = ldfo(AH + 16 * R2_S72, F72), a11 = ldfo(AH + 16 * R2_S72 + 32, F72), l0 = ldfo(LAK, F40), l1 = ldfo(LAK + 16 * R2_S40, F40);
            f32x4 ac0 = {0.f, 0.f, 0.f, 0.f}, ac1 = {0.f, 0.f, 0.f, 0.f};
            ac0 = MFMA16(a00, sb0, ac0); ac1 = MFMA16(a10, sb0, ac1); ac0 = MFMA16(a01, sb1, ac0); ac1 = MFMA16(a11, sb1, ac1); ac0 = MFMA16(l0, vb, ac0); ac1 = MFMA16(l1, vb, ac1);
            st_no(W1T + 16 * vt * R2_S40, N40, ac0); st_no(W1T + 16 * vt * R2_S40 + 16, N40, ac1);
        } else if (mode == 0) {
            R2_LANE(); R2_FOFF();
            const bf16x8 a00 = ldfo(AH, F72), a01 = ldfo(AH + 32, F72), a10 = ldfo(AH + 16 * R2_S72, F72), a11 = ldfo(AH + 16 * R2_S72 + 32, F72);
#pragma unroll
            for (int xi = 0; xi < 2; ++xi) {
                const int xt = 2 * (wave - 2) + xi;
                const bf16x8 xb0 = ldfo(Xcur + 16 * xt * R2_S72, F72), xb1 = ldfo(Xcur + 16 * xt * R2_S72 + 32, F72);
                f32x4 ac0 = {0.f, 0.f, 0.f, 0.f}, ac1 = {0.f, 0.f, 0.f, 0.f};
                ac0 = MFMA16(a00, xb0, ac0); ac1 = MFMA16(a10, xb0, ac1); ac0 = MFMA16(a01, xb1, ac0); ac1 = MFMA16(a11, xb1, ac1);
                st_no(RHX + 16 * xt * R2_S40, N40, ac0); st_no(RHX + 16 * xt * R2_S40 + 16, N40, ac1);
            }
        }
        R2_BAR();
        const int it8 = wave & 1, vt8 = wave >> 1; (void)it8; (void)vt8;
        {
            R2_LANE(); R2_FOFF();
#define R2_PK2(x0, x1) __builtin_bit_cast(bf16x8, (v4u){pkbf((x0)[0], (x0)[1]), pkbf((x0)[2], (x0)[3]), pkbf((x1)[0], (x1)[1]), pkbf((x1)[2], (x1)[3])})
            const int ct = wave >> 1, vtb = 2 * (wave & 1);
            const bf16x8 tm0 = ldfo(TM, F40), tm1 = ldfo(TM + 16 * R2_S40, F40);
            const bf16x8 bgp = r2_trf(BGT, 4 * q, 16 + 4 * q, 16 * ct, n), kgf = r2_trf(KGT, 8 * q, 8 * q + 4, 16 * ct, n);
            const f32x4 g4 = *(const LAS f32x4*)(GC + 16 * ct + 4 * q);
            const f32x4 z4 = {0.f, 0.f, 0.f, 0.f};
#pragma unroll
            for (int vi = 0; vi < 2; ++vi) {
                const int vt = vtb + vi;
                const bf16x8 wf = ldfo(W1T + 16 * vt * R2_S40, F40), xf = ldfo(RHX + 16 * vt * R2_S40, F40), vf = r2_trf(VT, 8 * q, 8 * q + 4, 16 * vt, n);
                f32x4 u0 = z4, u1 = z4, x0 = z4, x1 = z4;
                u0 = MFMA16(tm0, wf, u0); u1 = MFMA16(tm1, wf, u1); x0 = MFMA16(tm0, xf, x0); x1 = MFMA16(tm1, xf, x1);
                const bf16x8 ub = R2_PK2(u0, u1), xb = R2_PK2(x0, x1);
                f32x4 a = accS[vi] * g4, ax = accX[vi] * g4;
                a = MFMA16(kgf, vf, a); a = MFMA16(bgp, ub, a); ax = MFMA16(bgp, xb, ax);
                accS[vi] = a; accX[vi] = ax;
                st_no(Snxt + 16 * vt * R2_S72 + 16 * ct, N72, a); st_no(Xnxt + 16 * vt * R2_S72 + 16 * ct, N72, ax);
            }
#undef R2_PK2
                {
                    unsigned char* cp = CAu + (size_t)((t0 >> 5) & 31) * 10240; const int p = wave * 64 + lane;
                    const v4u c0 = (p < 480) ? *(const LAS v4u*)(lds + R2_LAK + 16 * p) : *(const LAS v4u*)(lds + R2_TM + 16 * (p - 480));
                    *(v4u*)(cp + 16 * p) = c0;
                    if (wave < 2) { const v4u c1 = *(const LAS v4u*)(lds + R2_TM + 16 * (32 + p)); *(v4u*)(cp + 16 * (512 + p)) = c1; }
                }
        }
        R2_BAR();
        }
        if (mode == 1) {
            R2_LANE();
            const f32x4 y4 = *(const LAS f32x4*)(YS + tk * R2_F68 + c4);
            const float mean = red16((y4[0] + y4[1]) + (y4[2] + y4[3])) * (1.0f / 64.0f);
            const f32x2 d0 = (f32x2){y4[0], y4[1]} - mean, d1 = (f32x2){y4[2], y4[3]} - mean;
            const f32x2 dq = d0 * d0 + d1 * d1;
            const float var = red16(dq.x + dq.y) * (1.0f / 64.0f);
            const float rstd = __builtin_amdgcn_rsqf(var + 64e-5f), bo = BON[tk];
            const f32x4 lnw = *(const LAS f32x4*)(PAR + 9 * 64 + c4), lnb = *(const LAS f32x4*)(PAR + 10 * 64 + c4);
            const f32x2 g0 = {bflo(g2.x), bfhi(g2.x)}, g1 = {bflo(g2.y), bfhi(g2.y)};
            const f32x2 n0 = g0 * (f32x2){-1.4426950408889634f, -1.4426950408889634f}, n1 = g1 * (f32x2){-1.4426950408889634f, -1.4426950408889634f};
            const f32x2 e0 = (f32x2){__builtin_amdgcn_exp2f(n0.x), __builtin_amdgcn_exp2f(n0.y)} + (f32x2){1.f, 1.f}, e1 = (f32x2){__builtin_amdgcn_exp2f(n1.x), __builtin_amdgcn_exp2f(n1.y)} + (f32x2){1.f, 1.f};
            const f32x2 s0 = g0 * (f32x2){__builtin_amdgcn_rcpf(e0.x), __builtin_amdgcn_rcpf(e0.y)}, s1 = g1 * (f32x2){__builtin_amdgcn_rcpf(e1.x), __builtin_amdgcn_rcpf(e1.y)};
            const f32x2 o0 = (d0 * rstd * (f32x2){lnw[0], lnw[1]} + (f32x2){lnb[0], lnb[1]} + (f32x2){vv[0], vv[1]} * bo) * s0, o1 = (d1 * rstd * (f32x2){lnw[2], lnw[3]} + (f32x2){lnb[2], lnb[3]} + (f32x2){vv[2], vv[3]} * bo) * s1;
            const float o[4] = {o0.x, o0.y, o1.x, o1.y};
            u32x2 ow; ow.x = pkbf(o[0], o[1]); ow.y = pkbf(o[2], o[3]);
            *(u32x2*)(Y + m * 2048 + hc + c4) = ow;
        }
        sbuf ^= 1;
    }
    if (mode == 0) {
        const int q_ = lane0 >> 4, n_ = lane0 & 15, ct_ = wave >> 1;
#pragma unroll
        for (int vi = 0; vi < 2; ++vi)
#pragma unroll
            for (int r = 0; r < 4; ++r) { const int idx = (16 * ct_ + 4 * q_ + r) * 64 + 16 * (2 * (wave & 1) + vi) + n_; MGu[idx] = accX[vi][r]; MGu[4096 + idx] = accS[vi][r]; }
    }
    __syncthreads();
#undef R2_LANE
#undef R2_BAR
}

constexpr int E12_LD = 1032;
__device__ __forceinline__ void conv_e12_mfma(LAS unsigned char* lds, const float* W  , const float* g  , const float* muv  , const float* v1  , bf16* WT, const int tid, const int wave) {
    if ((int)blockIdx.x >= 128) return;
    LAS bf16* BT = (LAS bf16*)lds;
    __syncthreads();
    for (int it = tid; it < 8192; it += 512) {
        const int c = it >> 3, j4 = 4 * (it & 7);
        const f32x4 v = *(const f32x4*)(v1 + c * 32 + j4); const float mu = muv[c], om = 1.0f - mu;
#pragma unroll
        for (int e2 = 0; e2 < 4; ++e2) { BT[(j4 + e2) * E12_LD + c] = (bf16)f2bf(om * v[e2]); BT[(32 + j4 + e2) * E12_LD + c] = (bf16)f2bf(mu * v[e2]); }
    }
    __syncthreads();
    if (wave < 4) {
        int lane = (int)__builtin_amdgcn_mbcnt_hi(~0u, __builtin_amdgcn_mbcnt_lo(~0u, 0u)); asm volatile("" : "+v"(lane));
        const int q = lane >> 4, n = lane & 15, nt = wave, k0 = 16 * (int)blockIdx.x;
        const float* wrow = W + (size_t)(k0 + n) * ECOLS + 2048 + 8 * q;
        f32x4 acc = {0.f, 0.f, 0.f, 0.f};
#pragma unroll 1
        for (int kb = 0; kb < 32; kb += 8) {
            f32x4 wq[16];
#pragma unroll
            for (int u = 0; u < 8; ++u) { wq[2 * u] = *(const f32x4*)(wrow + 32 * (kb + u)); wq[2 * u + 1] = *(const f32x4*)(wrow + 32 * (kb + u) + 4); }
            asm volatile("s_waitcnt vmcnt(0)" ::: "memory");
#pragma unroll
            for (int u = 0; u < 8; ++u) {
                const f32x4 w0 = wq[2 * u], w1 = wq[2 * u + 1];
                const bf16x8 a = __builtin_bit_cast(bf16x8, (v4u){pkbf(w0[0], w0[1]), pkbf(w0[2], w0[3]), pkbf(w1[0], w1[1]), pkbf(w1[2], w1[3])});
                acc = MFMA16(a, ldfrag(BT + 16 * nt * E12_LD + 32 * (kb + u), E12_LD, lane), acc);
            }
        }
        const f32x4 g4 = *(const f32x4*)(g + k0 + 4 * q);
        *(u32x2*)(WT + (size_t)(ZC_E1 + 16 * nt + n) * 2048 + k0 + 4 * q) = (u32x2){pkbf(acc[0] * g4[0], acc[1] * g4[1]), pkbf(acc[2] * g4[2], acc[3] * g4[3])};
    }
    __syncthreads();
}

struct SguP { const float *lnw, *lnb, *ws, *bs; const unsigned long long *st1, *st2; };

constexpr int AT_KLD = 72, AT_VOFF = 36864, AT_CSOFF = 73728, AT_GOFF = 81920, AT_GLD = 264;
typedef short at_s16x4 __attribute__((ext_vector_type(4)));
__device__ __forceinline__ at_s16x4 at_tr(const LAS bf16* p) { return __builtin_bit_cast(at_s16x4, __builtin_amdgcn_ds_read_tr16_b64_v4i16((LAS at_s16x4*)p)); }
__device__ __forceinline__ void attn_v2_unit(LAS unsigned char* lds, int b, int g, int nb, const bf16* Z, bf16* Y, const float* COS, const float* SIN, const float* sinks, const int tid, const int wave) {
    LAS bf16* KS = (LAS bf16*)lds; LAS bf16* VS = (LAS bf16*)(lds + AT_VOFF); LAS float* CS = (LAS float*)(lds + AT_CSOFF); LAS bf16* GT = (LAS bf16*)(lds + AT_GOFF);
    const int hq = 4 * g + (wave >> 1); const float sink = sinks[hq];
    const size_t mq0 = (size_t)b * SEQ + nb * 128;
    v4u qraw[2][2];
    { const int l_ = tid & 63; const bf16* qp = Z + (mq0 + 64 * (wave & 1) + (l_ & 15)) * ZE + ZC_Q + hq * 64 + 8 * (l_ >> 4);
#pragma unroll
      for (int qt = 0; qt < 2; ++qt) { qraw[qt][0] = *(const v4u*)(qp + (size_t)16 * qt * ZE); qraw[qt][1] = *(const v4u*)(qp + (size_t)16 * qt * ZE + 32); } }
    __syncthreads();
    {
        int lane = tid & 63; asm volatile("" : "+v"(lane)); const int tt_ = wave * 64 + lane;
        const int pc = tt_ & 7, r0 = tt_ >> 3;
        v4u gq[8], kq[4], vq[4]; f32x4 cs[4][4];
#pragma unroll
        for (int i = 0; i < 8; ++i) { const int p = tt_ + 512 * i; gq[i] = *(const v4u*)(Z + (mq0 + (p >> 5)) * ZE + ZC_BG + 256 * g + 8 * (p & 31)); }
#pragma unroll
        for (int i = 0; i < 4; ++i) {
            const int fr = r0 + 64 * i, tt = (nb - 1) * 128 + fr; const bool valid = tt >= 0; const size_t mk = (size_t)b * SEQ + (valid ? tt : 0);
            kq[i] = *(const v4u*)(Z + mk * ZE + ZC_KB + g * 64 + 8 * pc); vq[i] = *(const v4u*)(Z + mk * ZE + ZC_VB + g * 64 + 8 * pc);
            if (pc < 2) { cs[i][0] = *(const f32x4*)(COS + mk * 8); cs[i][1] = *(const f32x4*)(COS + mk * 8 + 4); cs[i][2] = *(const f32x4*)(SIN + mk * 8); cs[i][3] = *(const f32x4*)(SIN + mk * 8 + 4); }
        }
#pragma unroll
        for (int i = 0; i < 8; ++i) { const int p = tt_ + 512 * i; *(LAS v4u*)(GT + (p >> 5) * AT_GLD + 8 * (p & 31)) = gq[i]; }
#pragma unroll
        for (int i = 0; i < 4; ++i) {
            const int fr = r0 + 64 * i; const bool valid = (nb - 1) * 128 + fr >= 0;
            v4u kw = kq[i];
            const unsigned q0_ = (unsigned)__builtin_amdgcn_update_dpp(0, (int)kw.x, 0xB1, 0xF, 0xF, true), q1_ = (unsigned)__builtin_amdgcn_update_dpp(0, (int)kw.y, 0xB1, 0xF, 0xF, true),
                           q2_ = (unsigned)__builtin_amdgcn_update_dpp(0, (int)kw.z, 0xB1, 0xF, 0xF, true), q3_ = (unsigned)__builtin_amdgcn_update_dpp(0, (int)kw.w, 0xB1, 0xF, 0xF, true);
            if (pc < 2) {
                if (pc == 0 && fr >= 128) { LAS float* cp = CS + (fr - 128) * 16; *(LAS f32x4*)cp = cs[i][0]; *(LAS f32x4*)(cp + 4) = cs[i][1]; *(LAS f32x4*)(cp + 8) = cs[i][2]; *(LAS f32x4*)(cp + 12) = cs[i][3]; }
                const float sg = (pc == 0) ? -1.0f : 1.0f;
                const float xm[8] = {bflo(kw.x), bfhi(kw.x), bflo(kw.y), bfhi(kw.y), bflo(kw.z), bfhi(kw.z), bflo(kw.w), bfhi(kw.w)};
                const float xp[8] = {bflo(q0_), bfhi(q0_), bflo(q1_), bfhi(q1_), bflo(q2_), bfhi(q2_), bflo(q3_), bfhi(q3_)};
                const float cc[8] = {cs[i][0][0], cs[i][0][1], cs[i][0][2], cs[i][0][3], cs[i][1][0], cs[i][1][1], cs[i][1][2], cs[i][1][3]}, sn[8] = {cs[i][2][0], cs[i][2][1], cs[i][2][2], cs[i][2][3], cs[i][3][0], cs[i][3][1], cs[i][3][2], cs[i][3][3]};
                float y[8];
#pragma unroll
                for (int j = 0; j < 8; ++j) y[j] = xm[j] * cc[j] + sg * (xp[j] * sn[j]);
                kw = (v4u){pkbf(y[0], y[1]), pkbf(y[2], y[3]), pkbf(y[4], y[5]), pkbf(y[6], y[7])};
            }
            const v4u zz = {0u, 0u, 0u, 0u};
            *(LAS v4u*)(KS + fr * AT_KLD + 8 * pc) = valid ? kw : zz;
            *(LAS v4u*)(VS + fr * AT_KLD + 8 * pc) = valid ? vq[i] : zz;
        }
    }
    __syncthreads();
    for (int blk = 0; blk < 2; ++blk) {
        int lane = tid & 63; asm volatile("" : "+v"(lane));
        const int qd = lane >> 4, n = lane & 15;
        const int q0 = 64 * (wave & 1) + 32 * blk, kt0 = q0 >> 5;
        const size_t m0 = (size_t)b * SEQ + nb * 128 + q0;
        bf16x8 qf[2][2];
#pragma unroll
        for (int qt = 0; qt < 2; ++qt) {
            const v4u w0 = qraw[qt][0], w1 = qraw[qt][1];
            float x[8] = {bflo(w0.x), bfhi(w0.x), bflo(w0.y), bfhi(w0.y), bflo(w0.z), bfhi(w0.z), bflo(w0.w), bfhi(w0.w)};
            unsigned p0, p1, p2, p3;
            { const auto s0_ = __builtin_amdgcn_permlane16_swap(w0.x, w0.x, false, false), s1_ = __builtin_amdgcn_permlane16_swap(w0.y, w0.y, false, false), s2_ = __builtin_amdgcn_permlane16_swap(w0.z, w0.z, false, false), s3_ = __builtin_amdgcn_permlane16_swap(w0.w, w0.w, false, false);
              const bool odd = (qd & 1) != 0; p0 = odd ? (unsigned)s0_[0] : (unsigned)s0_[1]; p1 = odd ? (unsigned)s1_[0] : (unsigned)s1_[1]; p2 = odd ? (unsigned)s2_[0] : (unsigned)s2_[1]; p3 = odd ? (unsigned)s3_[0] : (unsigned)s3_[1]; }
            const float y[8] = {bflo(p0), bfhi(p0), bflo(p1), bfhi(p1), bflo(p2), bfhi(p2), bflo(p3), bfhi(p3)};
            const LAS float* cp = CS + (q0 + 16 * qt + n) * 16;
            const f32x4 c0 = *(const LAS f32x4*)cp, c1 = *(const LAS f32x4*)(cp + 4), s0 = *(const LAS f32x4*)(cp + 8), s1 = *(const LAS f32x4*)(cp + 12);
            const float cs[8] = {c0[0], c0[1], c0[2], c0[3], c1[0], c1[1], c1[2], c1[3]}, sn[8] = {s0[0], s0[1], s0[2], s0[3], s1[0], s1[1], s1[2], s1[3]};
#pragma unroll
            for (int i = 0; i < 8; ++i) { const float r0 = x[i] * cs[i] - y[i] * sn[i], r1 = x[i] * cs[i] + y[i] * sn[i]; x[i] = (qd == 0) ? r0 : (qd == 1) ? r1 : x[i]; }
            const v4u a = {pkbf(x[0] * 0.125f, x[1] * 0.125f), pkbf(x[2] * 0.125f, x[3] * 0.125f), pkbf(x[4] * 0.125f, x[5] * 0.125f), pkbf(x[6] * 0.125f, x[7] * 0.125f)};
            const v4u bq = {pkbf(bflo(w1.x) * 0.125f, bfhi(w1.x) * 0.125f), pkbf(bflo(w1.y) * 0.125f, bfhi(w1.y) * 0.125f), pkbf(bflo(w1.z) * 0.125f, bfhi(w1.z) * 0.125f), pkbf(bflo(w1.w) * 0.125f, bfhi(w1.w) * 0.125f)};
            qf[qt][0] = __builtin_bit_cast(bf16x8, a); qf[qt][1] = __builtin_bit_cast(bf16x8, bq);
        }
        if (blk == 0) { const bf16* qp = Z + (m0 + 32 + n) * ZE + ZC_Q + hq * 64 + 8 * qd;
#pragma unroll
            for (int qt = 0; qt < 2; ++qt) { qraw[qt][0] = *(const v4u*)(qp + (size_t)16 * qt * ZE); qraw[qt][1] = *(const v4u*)(qp + (size_t)16 * qt * ZE + 32); } }
        f32x4 s[10][2];
        bf16x8 ka0 = ldfrag(KS + (32 * kt0) * AT_KLD, AT_KLD, lane), ka1 = ldfrag(KS + (32 * kt0) * AT_KLD + 32, AT_KLD, lane);
#pragma unroll
        for (int kt = 0; kt < 10; ++kt) {
            const bf16x8 a0 = ka0, a1 = ka1;
            if (kt < 9) { ka0 = ldfrag(KS + (32 * kt0 + 16 * (kt + 1)) * AT_KLD, AT_KLD, lane); ka1 = ldfrag(KS + (32 * kt0 + 16 * (kt + 1)) * AT_KLD + 32, AT_KLD, lane); }
#pragma unroll
            for (int qt = 0; qt < 2; ++qt) { f32x4 acc = {0.f, 0.f, 0.f, 0.f}; if (kt - qt >= 0 && kt - qt <= 8) { acc = MFMA16(a0, qf[qt][0], acc); acc = MFMA16(a1, qf[qt][1], acc); } s[kt][qt] = acc; }
        }
        float inv[2];
#pragma unroll
        for (int qt = 0; qt < 2; ++qt) {
            float mx = sink;
#pragma unroll
            for (int kt = 0; kt < 10; ++kt) {
                const int d = kt - qt; if (d < 0 || d > 8) continue;
                const bool tok = (nb > 0) || (kt >= 8 - 2 * kt0);
#pragma unroll
                for (int r = 0; r < 4; ++r) { const bool valid = tok && (d != 0 || 4 * qd + r > n) && (d != 8 || 4 * qd + r <= n); const float v = valid ? s[kt][qt][r] : -INFINITY; s[kt][qt][r] = v; mx = fmaxf(mx, v); }
            }
            { const unsigned um = __builtin_bit_cast(unsigned, mx); const auto a_ = __builtin_amdgcn_permlane16_swap(um, um, false, false);
              mx = fmaxf(__builtin_bit_cast(float, (unsigned)a_[0]), __builtin_bit_cast(float, (unsigned)a_[1]));
              const unsigned un = __builtin_bit_cast(unsigned, mx); const auto b_ = __builtin_amdgcn_permlane32_swap(un, un, false, false);
              mx = fmaxf(__builtin_bit_cast(float, (unsigned)b_[0]), __builtin_bit_cast(float, (unsigned)b_[1])); }
            float l = 0.f;
#pragma unroll
            for (int kt = 0; kt < 10; ++kt) {
                const int d = kt - qt; if (d < 0 || d > 8) { s[kt][qt] = (f32x4){0.f, 0.f, 0.f, 0.f}; continue; }
#pragma unroll
                for (int r = 0; r < 4; ++r) { const float p = fexp(s[kt][qt][r] - mx); s[kt][qt][r] = p; l += p; }
            }
            l = pg8::rowsum4(l);
            inv[qt] = 1.0f / (l + fexp(sink - mx));
        }
        f32x4 o[4][2];
#pragma unroll
        for (int dt = 0; dt < 4; ++dt) { o[dt][0] = (f32x4){0.f, 0.f, 0.f, 0.f}; o[dt][1] = o[dt][0]; }
#pragma unroll
        for (int s5 = 0; s5 < 5; ++s5) {
            bf16x8 pf[2];
#pragma unroll
            for (int qt = 0; qt < 2; ++qt) { const v4u w = {pkbf(s[2 * s5][qt][0], s[2 * s5][qt][1]), pkbf(s[2 * s5][qt][2], s[2 * s5][qt][3]), pkbf(s[2 * s5 + 1][qt][0], s[2 * s5 + 1][qt][1]), pkbf(s[2 * s5 + 1][qt][2], s[2 * s5 + 1][qt][3])}; pf[qt] = __builtin_bit_cast(bf16x8, w); }
            at_s16x4 vt0[4], vt1[4];
#pragma unroll
            for (int dt = 0; dt < 4; ++dt) {
                const LAS bf16* vp = VS + (32 * (kt0 + s5) + 4 * qd + (n >> 2)) * AT_KLD + 16 * dt + 4 * (n & 3);
                vt0[dt] = at_tr(vp); vt1[dt] = at_tr(vp + 16 * AT_KLD);
            }
#pragma unroll
            for (int dt = 0; dt < 4; ++dt) {
                const bf16x8 a = {vt0[dt][0], vt0[dt][1], vt0[dt][2], vt0[dt][3], vt1[dt][0], vt1[dt][1], vt1[dt][2], vt1[dt][3]};
                o[dt][0] = MFMA16(a, pf[0], o[dt][0]); o[dt][1] = MFMA16(a, pf[1], o[dt][1]);
            }
        }
#pragma unroll
        for (int qt = 0; qt < 2; ++qt) {
            LAS bf16* gp = GT + (q0 + 16 * qt + n) * AT_GLD + (wave >> 1) * 64 + 4 * qd;
#pragma unroll
            for (int dt = 0; dt < 4; ++dt) {
                const u32x2 gw = *(const LAS u32x2*)(gp + 16 * dt);
                const float g0 = bflo(gw.x), g1 = bfhi(gw.x), g2 = bflo(gw.y), g3 = bfhi(gw.y);
                const f32x4 ov = o[dt][qt] * inv[qt];
                *(LAS u32x2*)(gp + 16 * dt) = (u32x2){pkbf(ov[0] * siluf_(g0), ov[1] * siluf_(g1)), pkbf(ov[2] * siluf_(g2), ov[3] * siluf_(g3))};
            }
        }
        asm volatile("s_waitcnt lgkmcnt(0)" ::: "memory");
#pragma unroll
        for (int i = 0; i < 4; ++i) {
            const int rr = 8 * i + (lane >> 3), pc = lane & 7;
            const v4u w = *(const LAS v4u*)(GT + (q0 + rr) * AT_GLD + (wave >> 1) * 64 + 8 * pc);
            *(v4u*)(Y + (m0 + rr) * 2048 + 1024 + hq * 64 + 8 * pc) = w;
        }
    }
}

constexpr int SG_LD = 136, SG_VOFF = 34816, SG_OOFF = 69632, SG_OLD = 132;
typedef short sg_s16x4 __attribute__((ext_vector_type(4)));
__device__ __forceinline__ sg_s16x4 sg_tr(const LAS bf16* p) { return __builtin_bit_cast(sg_s16x4, __builtin_amdgcn_ds_read_tr16_b64_v4i16((LAS sg_s16x4*)p)); }
__device__ __forceinline__ void sgu_v2(LAS unsigned char* lds, const SguP P, const bf16* Z, bf16* Y, int G, const int tid, const int wave) {
    LAS bf16* WM = (LAS bf16*)lds; LAS bf16* VVT = (LAS bf16*)(lds + SG_VOFF);
    const int ng = G / 16; if ((int)blockIdx.x >= ng * 16) return;
    const int g = blockIdx.x & 15;
    __syncthreads();
    {
        float wv[32];
#pragma unroll
        for (int i = 0; i < 32; ++i) wv[i] = P.ws[(size_t)g * 16384 + tid + 512 * i];
#pragma unroll
        for (int i = 0; i < 32; ++i) { const int idx = tid + 512 * i, t = idx >> 7, s = idx & 127; WM[t * SG_LD + s] = (bf16)f2bf((t >= s) ? wv[i] : 0.f); }
    }
#define SG_BAR() asm volatile("s_waitcnt lgkmcnt(0)\n\ts_barrier" ::: "memory")
    LAS bf16* VN = VVT;
    const int tt0 = wave * 64 + (tid & 63), pc0 = tt0 & 15, rr0 = tt0 >> 4;
    const f32x4 lw0 = *(const f32x4*)(P.lnw + g * 128 + 8 * pc0), lw1 = *(const f32x4*)(P.lnw + g * 128 + 8 * pc0 + 4), lb0 = *(const f32x4*)(P.lnb + g * 128 + 8 * pc0), lb1 = *(const f32x4*)(P.lnb + g * 128 + 8 * pc0 + 4);
    v4u pv[4]; unsigned long long ps1[4], ps2[4];
    v4u nuw[4];
    LAS float* OT = (LAS float*)(lds + SG_OOFF);
    float bsr[4];
#pragma unroll
    for (int i = 0; i < 4; ++i) bsr[i] = P.bs[g * 128 + rr0 + 32 * i];
    {
        const int p0 = blockIdx.x >> 4;
        if (p0 < 128) { const size_t mm0 = (size_t)(p0 >> 6) * SEQ + (p0 & 63) * 128;
#pragma unroll
            for (int i = 0; i < 4; ++i) { const size_t m = mm0 + rr0 + 32 * i; pv[i] = *(const v4u*)(Z + m * ZO2 + 2048 + g * 128 + 8 * pc0); ps1[i] = P.st1[m]; ps2[i] = P.st2[m]; }
#pragma unroll
            for (int i = 0; i < 4; ++i) { const size_t m = mm0 + rr0 + 32 * i; nuw[i] = *(const v4u*)(Z + m * ZO2 + g * 128 + 8 * pc0); } }
    }
    SG_BAR();
    for (int p = blockIdx.x >> 4; p < 128; p += ng) {
        const int b = p >> 6, nc = p & 63; const size_t m0 = (size_t)b * SEQ + nc * 128;
        int lane = tid & 63; asm volatile("" : "+v"(lane));
        const int qd = lane >> 4, n = lane & 15;
        {
            const int tt_ = wave * 64 + lane; const int pc = tt_ & 15, rr = tt_ >> 4;
#pragma unroll
            for (int i = 0; i < 4; ++i) {
                const float mean = (float)(long long)ps1[i] * (1.0f / 16777216.0f) * (1.0f / 2048.0f), var = (float)(long long)ps2[i] * (1.0f / 16777216.0f) * (1.0f / 2048.0f) - mean * mean, rstd = __builtin_amdgcn_rsqf(var + 1e-5f);
                const v4u w = pv[i];
                const f32x4 x0 = {bflo(w.x), bfhi(w.x), bflo(w.y), bfhi(w.y)}, x1 = {bflo(w.z), bfhi(w.z), bflo(w.w), bfhi(w.w)};
                const f32x4 y0 = (x0 - mean) * rstd * lw0 + lb0, y1 = (x1 - mean) * rstd * lw1 + lb1;
                *(LAS v4u*)(VN + (rr + 32 * i) * SG_LD + 8 * pc) = (v4u){pkbf(y0[0], y0[1]), pkbf(y0[2], y0[3]), pkbf(y1[0], y1[1]), pkbf(y1[2], y1[3])};
            }
            const int pn = p + ng;
            if (pn < 128) { const size_t mm0 = (size_t)(pn >> 6) * SEQ + (pn & 63) * 128;
#pragma unroll
                for (int i = 0; i < 4; ++i) { const size_t m = mm0 + rr + 32 * i; pv[i] = *(const v4u*)(Z + m * ZO2 + 2048 + g * 128 + 8 * pc); ps1[i] = P.st1[m]; ps2[i] = P.st2[m]; } }
        }
        const int pcu = (wave * 64 + lane) & 15, rru = (wave * 64 + lane) >> 4;
        v4u uw[4];
#pragma unroll
        for (int i = 0; i < 4; ++i) uw[i] = nuw[i];
        { const int pn = p + ng; if (pn < 128) { const size_t mm0 = (size_t)(pn >> 6) * SEQ + (pn & 63) * 128;
#pragma unroll
            for (int i = 0; i < 4; ++i) { const size_t m = mm0 + rru + 32 * i; nuw[i] = *(const v4u*)(Z + m * ZO2 + g * 128 + 8 * pcu); } } }
        SG_BAR();
        f32x4 acc[8];
#pragma unroll
        for (int tt = 0; tt < 8; ++tt) acc[tt] = (f32x4){0.f, 0.f, 0.f, 0.f};
#pragma unroll
        for (int ks = 0; ks < 4; ++ks) {
            const LAS bf16* tp = VN + (32 * ks + 8 * qd + (n >> 2)) * SG_LD + 16 * wave + 4 * (n & 3);
            const sg_s16x4 t0 = sg_tr(tp), t1 = sg_tr(tp + 4 * SG_LD);
            bf16x8 bq[8];
#pragma unroll
            for (int tt = 2 * ks; tt < 8; ++tt) bq[tt] = ldfrag(WM + 16 * tt * SG_LD + 32 * ks, SG_LD, lane);
            const bf16x8 a = {t0[0], t0[1], t0[2], t0[3], t1[0], t1[1], t1[2], t1[3]};
#pragma unroll
            for (int tt = 2 * ks; tt < 8; ++tt) acc[tt] = MFMA16(a, bq[tt], acc[tt]);
        }
#pragma unroll
        for (int tt = 0; tt < 8; ++tt) *(LAS f32x4*)(OT + (16 * tt + n) * SG_OLD + 16 * wave + 4 * qd) = acc[tt];
        SG_BAR();
#pragma unroll
        for (int i = 0; i < 4; ++i) {
            const int t = rru + 32 * i; const size_t m = m0 + t; const float bsv = bsr[i];
            const f32x4 o0 = *(const LAS f32x4*)(OT + t * SG_OLD + 8 * pcu), o1 = *(const LAS f32x4*)(OT + t * SG_OLD + 8 * pcu + 4);
            const v4u w = uw[i];
            const f32x4 u0 = {bflo(w.x), bfhi(w.x), bflo(w.y), bfhi(w.y)}, u1 = {bflo(w.z), bfhi(w.z), bflo(w.w), bfhi(w.w)};
            const f32x4 y0 = u0 * (o0 + bsv), y1 = u1 * (o1 + bsv);
            *(v4u*)(Y + m * 2048 + g * 128 + 8 * pcu) = (v4u){pkbf(y0[0], y0[1]), pkbf(y0[2], y0[3]), pkbf(y1[0], y1[1]), pkbf(y1[2], y1[3])};
        }
    }
#undef SG_BAR
    __syncthreads();
}

struct Args { const void* in[27]; float* out; unsigned char* ws; int ph_lo, ph_hi, li, pad; };
enum { I_X = 0, I_POS, I_ENORM, I_EWIN, I_EMU, I_W0, I_W2, I_A0, I_A2, I_KK, I_KA, I_RK, I_LNW, I_LNB, I_V0, I_V1, I_V2, I_SINK, I_EWOUT, I_ONORM, I_OWIN, I_SLNW, I_SLNB, I_SWS, I_SBS, I_OWOUT, I_FNORM };

typedef const __attribute__((address_space(4))) Args* KArgP;
__device__ __forceinline__ KArgP kargs() { KArgP p = (KArgP)__builtin_amdgcn_kernarg_segment_ptr(); asm volatile("" : "+s"(p)); return p; }
__global__ void __launch_bounds__(NWAVES * 64, 2) hybrid_fwd(Args args_) {
    extern __shared__ __attribute__((aligned(16))) unsigned char lds_raw[];
    LAS unsigned char* lds = (LAS unsigned char*)lds_raw;
    volatile LAS unsigned* MISC = (volatile LAS unsigned*)(lds + MISC_OFF);
    const int wave = __builtin_amdgcn_readfirstlane(threadIdx.x >> 6);
    const int G = gridDim.x, gw = blockIdx.x * NWAVES + wave, NGW = G * NWAVES, NGT = G * NWAVES * 64;
    (void)args_;

    for (int u = threadIdx.x; u < (LDS_BYTES - LDSCTL_OFF) / 4; u += NWAVES * 64) ((LAS unsigned*)(lds + LDSCTL_OFF))[u] = 0u;
    __syncthreads();
    XcdBarrier bar; { KArgP a0 = kargs(); bar = xcd_barrier_post((unsigned*)(a0->ws + WS_CTL) + CW_BAR + a0->li * XCD_BAR_WORDS, MISC + 8); }
    LAS float* scr = (LAS float*)(lds + RING_OFF + wave * 16640);

    const int ph_lo = kargs()->ph_lo, ph_hi = kargs()->ph_hi;
    for (int ph = ph_lo; ph < ph_hi; ++ph) {
        KArgP args = kargs();
        int lane = (int)__builtin_amdgcn_mbcnt_hi(~0u, __builtin_amdgcn_mbcnt_lo(~0u, 0u)); asm volatile("" : "+v"(lane));
        const int tid = wave * 64 + lane, gtid = blockIdx.x * (NWAVES * 64) + tid;
        unsigned char* ws = args->ws;
        unsigned long long* STAT = (unsigned long long*)(ws + WS_STAT);
        float* COS = (float*)(ws + WS_ROPE); float* SIN = COS + (size_t)M * 8;
        bf16* WEIN = (bf16*)(ws + WS_WEIN); bf16* WOIN = (bf16*)(ws + WS_WOIN); bf16* WEOUT = (bf16*)(ws + WS_WEOUT); bf16* WOOUT = (bf16*)(ws + WS_WOOUT);
        bf16* XB = (bf16*)(ws + WS_XB); bf16* Y = (bf16*)(ws + WS_Y); bf16* VF = (bf16*)(ws + WS_VF); bf16* Z = (bf16*)(ws + WS_Z);
        const float* x_in = (const float*)args->in[I_X]; float* out = args->out;
        const int ptype = (int)((PH_TYPE >> (4 * ph)) & 15), L = (int)((PH_LAYER >> (4 * ph)) & 15), idx = L >> 1; const bool even = (L & 1) == 0;
        float* MG = out;
        if (ptype == 0) {
            for (int i = gtid; i < 8 * M; i += NGT) STAT[M + i] = 0ull;
            for (int m = gw; m < M; m += NGW) {
                const GAS f32x4* xr = (const GAS f32x4*)(x_in + (size_t)m * DM) + lane; GAS unsigned long long* o8 = (GAS unsigned long long*)(XB + (size_t)m * DM) + lane; float s = 0.f;
                const f32x4 v0 = xr[0], v1 = xr[64], v2 = xr[128], v3 = xr[192], v4 = xr[256], v5 = xr[320], v6 = xr[384], v7 = xr[448];
                asm volatile("s_waitcnt vmcnt(0)" ::: "memory");
#define P0_ROW(v, j) { s += ((v).x * (v).x + (v).y * (v).y) + ((v).z * (v).z + (v).w * (v).w); o8[64 * (j)] = (unsigned long long)pkbf((v).x, (v).y) | ((unsigned long long)pkbf((v).z, (v).w) << 32); }
                P0_ROW(v0, 0) P0_ROW(v1, 1) P0_ROW(v2, 2) P0_ROW(v3, 3) P0_ROW(v4, 4) P0_ROW(v5, 5) P0_ROW(v6, 6) P0_ROW(v7, 7)
#undef P0_ROW
                s = wave_sum(s); if (lane == 0) STAT[m] = (unsigned long long)(long long)(s * 16777216.0f);
            }
            { const int* pos = (const int*)args->in[I_POS];
              for (int i = gtid; i < M * 8; i += NGT) { const int m = i >> 3, k = i & 7; const float invf = powf(500000.0f, -(float)k * 0.125f); const float ang = (float)pos[m] * invf; COS[i] = cosf(ang); SIN[i] = sinf(ang); } }
            conv_weight((const float*)args->in[I_EWIN], ECOLS, (const float*)args->in[I_ENORM], WEIN, 1, scr, gw, NGW, lane);
            zero_rows(WEIN, ZC_E1, ZC_Q, gtid, NGT);
            { const int r1 = (32 * (ECOLS / 64)) % NGW, r2 = (r1 + 1024) % NGW, r3 = (r2 + 1024) % NGW, r4 = (r3 + 1024) % NGW;
              conv_weight((const float*)args->in[I_EWOUT], 2048, nullptr, WEOUT, 0, scr, (gw + NGW - r1) % NGW, NGW, lane);
              conv_weight((const float*)args->in[I_EWOUT] + (size_t)2048 * 2048, 2048, nullptr, WEOUT + (size_t)2048 * 2048, 0, scr, (gw + NGW - r2) % NGW, NGW, lane);
              conv_weight((const float*)args->in[I_OWOUT], 2048, nullptr, WOOUT, 0, scr, (gw + NGW - r3) % NGW, NGW, lane);
              conv_weight((const float*)args->in[I_OWOUT] + (size_t)2048 * 2048, 2048, nullptr, WOOUT + (size_t)2048 * 2048, 0, scr, (gw + NGW - r4) % NGW, NGW, lane); }
        } else if (ptype == 5) {
            const float* fn = (const float*)args->in[I_FNORM]; const unsigned long long* ssq = STAT + (size_t)4 * M;
            {
                const GAS f32x4* gr = (const GAS f32x4*)fn + 2 * lane;
                const f32x4 g0 = gr[0], g1 = gr[1], g2 = gr[128], g3 = gr[129], g4 = gr[256], g5 = gr[257], g6 = gr[384], g7 = gr[385];
                for (int m = gw; m < M; m += NGW) {
                    const GAS v4u* xr = (const GAS v4u*)(XB + (size_t)m * DM) + lane; GAS f32x4* orow = (GAS f32x4*)(out + (size_t)m * DM) + 2 * lane;
                    const v4u w0 = xr[0], w1 = xr[64], w2 = xr[128], w3 = xr[192]; const unsigned long long sc = ssq[m];
                    asm volatile("s_waitcnt vmcnt(0)" ::: "memory");
                    const float rs = 1.0f / sqrtf((float)(long long)sc * (1.0f / 16777216.0f) * (1.0f / 2048.0f) + 1e-5f);
#define FN_ROW(q_, j, ga, gb) { orow[128 * (j)] = (f32x4){bflo((q_).x), bfhi((q_).x), bflo((q_).y), bfhi((q_).y)} * rs * (ga); orow[128 * (j) + 1] = (f32x4){bflo((q_).z), bfhi((q_).z), bflo((q_).w), bfhi((q_).w)} * rs * (gb); }
                    FN_ROW(w0, 0, g0, g1) FN_ROW(w1, 1, g2, g3) FN_ROW(w2, 2, g4, g5) FN_ROW(w3, 3, g6, g7)
#undef FN_ROW
                }
            }
        } else {
            if (ptype == 1) {
                const int N = even ? ZE : ZO;
                pg8::Gemm g{XB, even ? WEIN : WOIN, M, N, DM}; pg8::StaticOrder S; S.init(M, N, G, (int)blockIdx.x);
                LAS float* rst = (LAS float*)(lds + RST_OFF);
                { const unsigned long long* ssq = STAT + (size_t)L * M; unsigned long long sv[4];
#pragma unroll
                  for (int i = 0; i < 4; ++i) { pg8::Unit uu; const int ui = (tid >> 8) + 2 * i; const bool ok = S.next(ui, uu); sv[i] = ssq[(ok ? uu.pm : 0) * 256 + (tid & 255)]; }
#pragma unroll
                  for (int i = 0; i < 4; ++i) { const int ui = (tid >> 8) + 2 * i; rst[ui * 256 + (tid & 255)] = __builtin_amdgcn_rsqf((float)(long long)sv[i] * (1.0f / 16777216.0f) * (1.0f / 2048.0f) + 1e-5f); }
                  __syncthreads(); }
                pg8::EpiZ E{Z, even ? ZE : ZO2, lds + RST_OFF + 8192, rst, STAT + (size_t)(5 + idx) * M, STAT + (size_t)(7 + idx) * M, even ? 0 : 16, even ? 0 : 24, even ? 0 : 16};
                pg8::gemm_phase<pg8::EpiZ, pg8::StaticOrder, PG8_ALIGN, PG8_SP2>(lds + RING_OFF, g, S, E, tid);
                if (even && (int)blockIdx.x >= 192 && G == 256)
                    conv_weight((const float*)args->in[I_OWIN] + (size_t)idx * 2048 * OCOLS, OCOLS, (const float*)args->in[I_ONORM] + idx * 2048, WOIN, 2, scr, ((int)blockIdx.x - 192) * NWAVES + wave, 64 * NWAVES, lane);
                else if (even && G != 256)
                    conv_weight((const float*)args->in[I_OWIN] + (size_t)idx * 2048 * OCOLS, OCOLS, (const float*)args->in[I_ONORM] + idx * 2048, WOIN, 2, scr, gw, NGW, lane);
            } else if (ptype == 4) {
                pg8::Gemm g{Y, (even ? WEOUT : WOOUT) + (size_t)idx * 2048 * 2048, M, DM, DM}; pg8::StaticOrder S; S.init(M, DM, G, (int)blockIdx.x);
                pg8::EpiX E{XB, STAT + (size_t)(L + 1) * M, lds + RST_OFF + 8192};
                pg8::gemm_phase<pg8::EpiX, pg8::StaticOrder, PG8_ALIGN, PG8_SP2>(lds + RING_OFF, g, S, E, tid);
            } else if (even) {
                RwkvP P; P.e = idx;
                P.mu = (const float*)args->in[I_EMU] + idx * 3200; P.w0 = (const float*)args->in[I_W0] + idx * 1024; P.w2 = (const float*)args->in[I_W2] + (size_t)idx * 64 * 1024;
                P.a0 = (const float*)args->in[I_A0] + idx * 1024; P.a2 = (const float*)args->in[I_A2] + (size_t)idx * 64 * 1024; P.kk = (const float*)args->in[I_KK] + idx * 1024; P.ka = (const float*)args->in[I_KA] + idx * 1024;
                P.rk = (const float*)args->in[I_RK] + idx * 1024; P.lnw = (const float*)args->in[I_LNW] + idx * 1024; P.lnb = (const float*)args->in[I_LNB] + idx * 1024;
                P.v0 = (const float*)args->in[I_V0]; P.v2 = (const float*)args->in[I_V2];
                if (ptype == 2) {
                    if (idx == 0) {
                        conv_weight((const float*)args->in[I_EWIN] + (size_t)2048 * ECOLS, ECOLS, (const float*)args->in[I_ENORM] + 2048, WEIN, 1, scr, gw, NGW, lane);
                        zero_rows(WEIN, ZC_E2 + 32, ZC_Q, gtid, NGT);
                        conv_e12_mfma(lds + RING_OFF, (const float*)args->in[I_EWIN] + (size_t)2048 * ECOLS, (const float*)args->in[I_ENORM] + 2048, (const float*)args->in[I_EMU] + 3200 + 2048, (const float*)args->in[I_V1], WEIN, tid, wave);
                        __syncthreads();
                    }
                    for (int u = blockIdx.x; u < 256; u += G) rwkv_v2(lds + RING_OFF, P, u >> 7, (u >> 3) & 15, u & 7, 0, Z, Y, VF, MG, (unsigned char*)out + 16 * MiB, tid, wave);
                } else {
                    for (int u = blockIdx.x; u < 256; u += G) rwkv_v2(lds + RING_OFF, P, u >> 7, (u >> 3) & 15, u & 7, 1, Z, Y, VF, MG, (unsigned char*)out + 16 * MiB, tid, wave);
                    const float* sinks = (const float*)args->in[I_SINK] + idx * 16;
                    for (int u = (int)blockIdx.x; u < 512; u += G) attn_v2_unit(lds + RING_OFF, u >> 8, (u >> 6) & 3, u & 63, Z, Y, COS, SIN, sinks, tid, wave);
                }
            } else {
                SguP P; P.lnw = (const float*)args->in[I_SLNW] + idx * 2048; P.lnb = (const float*)args->in[I_SLNB] + idx * 2048; P.ws = (const float*)args->in[I_SWS] + (size_t)idx * 16 * 16384; P.bs = (const float*)args->in[I_SBS] + idx * 2048;
                P.st1 = STAT + (size_t)(5 + idx) * M; P.st2 = STAT + (size_t)(7 + idx) * M;
                sgu_v2(lds + RING_OFF, P, Z, Y, G, tid, wave);
            }
        }
        if (ph + 1 < ph_hi) xcd_barrier(bar, tid);
    }
}

extern "C" void kernel_launch(void* const* d_in, const int* in_sizes, int n_in, void* d_out, int out_size, void* d_ws, size_t ws_size, hipStream_t stream) {
    static int grid = 0;
    if (grid == 0) {
        if (n_in != 27 || in_sizes[0] != M * DM || out_size != M * DM || ws_size < WS_END) { fprintf(stderr, "kernel_launch: unexpected shapes (n_in %d, in0 %d, out %d, ws %zu); nothing launched\n", n_in, n_in > 0 ? in_sizes[0] : -1, out_size, ws_size); grid = -1; return; }
        int dev = 0, cus = 0, per_cu = 0;
        if (hipGetDevice(&dev) != hipSuccess || hipDeviceGetAttribute(&cus, hipDeviceAttributeMultiprocessorCount, dev) != hipSuccess) { fprintf(stderr, "kernel_launch: device query failed\n"); grid = -1; return; }
        if (hipFuncSetAttribute((const void*)hybrid_fwd, hipFuncAttributeMaxDynamicSharedMemorySize, LDS_BYTES) != hipSuccess) { fprintf(stderr, "kernel_launch: hipFuncSetAttribute failed\n"); grid = -1; return; }
        if (hipOccupancyMaxActiveBlocksPerMultiprocessor(&per_cu, (const void*)hybrid_fwd, NWAVES * 64, LDS_BYTES) != hipSuccess || per_cu < 1) fprintf(stderr, "kernel_launch: note: occupancy query reports %d workgroups per CU\n", per_cu);
        (void)hipGetLastError();
        grid = cus;
    }
    if (grid < 0) return;
    if (hipMemsetAsync((char*)d_ws + WS_CTL, 0, CTL_ZERO_BYTES, stream) != hipSuccess) { fprintf(stderr, "kernel_launch: memset failed\n"); return; }
    Args a{};
    for (int i = 0; i < 27; ++i) a.in[i] = d_in[i];
    a.out = (float*)d_out; a.ws = (unsigned char*)d_ws;
#if ONE_LAUNCH
    a.ph_lo = 0; a.ph_hi = N_PHASES; a.li = 0;
    hipLaunchKernelGGL(hybrid_fwd, dim3(grid), dim3(NWAVES * 64), LDS_BYTES, stream, a);
#else
    for (int p = 0; p < N_PHASES; ++p) { a.ph_lo = p; a.ph_hi = p + 1; a.li = p; hipLaunchKernelGGL(hybrid_fwd, dim3(grid), dim3(NWAVES * 64), LDS_BYTES, stream, a); }
#endif
    const hipError_t le = hipPeekAtLastError();
    if (le != hipSuccess) fprintf(stderr, "kernel_launch: launch failed: %s\n", hipGetErrorName(le));
}
```

```cpp
#include <hip/hip_runtime.h>
#include <cstdio>
#include <cstdint>

#ifndef ONE_LAUNCH
#define ONE_LAUNCH 1
#endif

namespace pg8 {
#define PG8_LAS __attribute__((address_space(3)))
typedef unsigned short bf16_t;
typedef short bf16x8 __attribute__((ext_vector_type(8)));
typedef float f32x4 __attribute__((ext_vector_type(4)));
typedef unsigned u32x4 __attribute__((ext_vector_type(4)));
constexpr int BM = 256, BK = 64, HALF = 128, HTB = HALF * BK * 2  , STAGE_BYTES = 8 * HTB, NXCD = 8, WGM = 8;

__host__ __device__ __forceinline__ int lds_byte(int r, int c) { const int st = (r >> 4) * 2 + (c >> 5), rr = r & 15, cc = c & 31, ob = rr * 64 + cc * 2; return st * 1024 + (ob ^ (((ob >> 9) & 1) << 5)); }
__host__ __device__ __forceinline__ void stage_rc(int b, int& R, int& C) { const int st = b / 1024, sb = b % 1024, swz = sb ^ (((sb >> 9) & 1) << 5); R = (st >> 1) * 16 + swz / 64; C = (st & 1) * 32 + (swz % 64) / 2; }
__host__ __device__ __forceinline__ int perm32(int rho) { const int n = rho >> 4, i = rho & 15; return 8 * (i >> 2) + 4 * n + (i & 3); }

struct Unit { int pm, pn; };
struct Gemm { const bf16_t* A; const bf16_t* Bt; int M, N, K; };

struct StaticOrder {
    int nM, nN, nwg, G, c;
    __host__ __device__ void init(int M, int N, int G_, int c_) { nM = M / BM; nN = N / BM; nwg = nM * nN; G = G_; c = c_; }
    __host__ __device__ bool next(int i, Unit& u) const {
        const long L = (long)i * G + c; if (L >= nwg) return false;
        int wgid = (int)L; { const int q = nwg / NXCD, r = nwg % NXCD, xcd = wgid % NXCD, off = wgid / NXCD; wgid = (xcd < r ? xcd * (q + 1) : r * (q + 1) + (xcd - r) * q) + off; }
        const int nig = WGM * nN, gid = wgid / nig, fm = gid * WGM, gsz = (nM - fm) < WGM ? (nM - fm) : WGM;
        u.pm = fm + ((wgid % nig) % gsz); u.pn = (wgid % nig) / gsz; return true;
    }
    __device__ __forceinline__ void a_ready(const Unit&) const {}
    __device__ __forceinline__ void done(const Unit&) const {}
};

typedef float f32x2_ __attribute__((ext_vector_type(2))); typedef __bf16 bf16x2_ __attribute__((ext_vector_type(2)));
__device__ __forceinline__ void fx_add(unsigned long long* p, float v) { atomicAdd(p, (unsigned long long)(long long)(v * 16777216.0f)); }
__device__ __forceinline__ float fx_get(const unsigned long long* p) { return (float)(long long)(*p) * (1.0f / 16777216.0f); }
__device__ __forceinline__ unsigned cvt_pk_bf16(float lo, float hi) { const f32x2_ v = {lo, hi}; const bf16x2_ b = __builtin_convertvector(v, bf16x2_); return __builtin_bit_cast(unsigned, b); }


__device__ __forceinline__ float rowsum4(float x) {
    const unsigned ux = __builtin_bit_cast(unsigned, x);
    const auto a = __builtin_amdgcn_permlane16_swap(ux, ux, false, false);
    const float y = __builtin_bit_cast(float, (unsigned)a[0]) + __builtin_bit_cast(float, (unsigned)a[1]);
    const unsigned uy = __builtin_bit_cast(unsigned, y);
    const auto b = __builtin_amdgcn_permlane32_swap(uy, uy, false, false);
    return __builtin_bit_cast(float, (unsigned)b[0]) + __builtin_bit_cast(float, (unsigned)b[1]);
}
__device__ __forceinline__ void st_wt(u32x4* p, const u32x4 w) { asm volatile("global_store_dwordx4 %0, %1, off sc1\n\ts_nop 1" :: "v"(p), "v"(w) : "memory"); }
struct EpiZ {
    static constexpr bool PERM = true, AFTER_DRAIN = false;
    bf16_t* Z; int ldz; PG8_LAS unsigned char* slab0;     const PG8_LAS float* rst;     unsigned long long* st1; unsigned long long* st2; int st_lo, st_hi; int ug_tiles;
    __device__ __forceinline__ void operator()(const f32x4 (&acc)[2][2][4][2], const Unit& u, int ui, int wr, int wc, int fr, int fq) const {
        const int row0 = u.pm * BM + wr * 64 + fr, col0 = u.pn * BM + wc * 64 + 8 * fq;
        const bool dost = (u.pn >= st_lo) && (u.pn < st_hi);
        int ln_ = fr + 16 * fq; asm volatile("" : "+v"(ln_));
        PG8_LAS unsigned char* const slw = slab0 + (wr * 4 + wc) * 2304 + (ln_ & 15) * 144 + (ln_ >> 4) * 16;
        PG8_LAS unsigned char* const slr = slab0 + (wr * 4 + wc) * 2304 + (ln_ >> 3) * 144 + (ln_ & 7) * 16;
        const int drow = (ln_ >> 3) - (ln_ & 15), dcol = 8 * (ln_ & 7);
        float rs8[8];
#pragma unroll
        for (int g = 0; g < 8; ++g) rs8[g] = rst[ui * BM + wr * 64 + fr + (g >> 2) * HALF + (g & 3) * 16];
        if (u.pn < ug_tiles) {
#pragma unroll
            for (int ai = 0; ai < 2; ++ai)
#pragma unroll
                for (int m = 0; m < 4; ++m) {
                    const int row = row0 + ai * HALF + m * 16;
                    const float rs = rs8[4 * ai + m];
                    const f32x4 u0 = acc[ai][0][m][0] * rs, u1 = acc[ai][0][m][1] * rs, g0 = acc[ai][1][m][0] * rs, g1 = acc[ai][1][m][1] * rs;
                    f32x4 o0, o1;
#pragma unroll
                    for (int k = 0; k < 4; ++k) { o0[k] = u0[k] * g0[k] * __builtin_amdgcn_rcpf(1.0f + __builtin_amdgcn_exp2f(-1.4426950408889634f * g0[k])); o1[k] = u1[k] * g1[k] * __builtin_amdgcn_rcpf(1.0f + __builtin_amdgcn_exp2f(-1.4426950408889634f * g1[k])); }
                    u32x4 w; w.x = cvt_pk_bf16(o0[0], o0[1]); w.y = cvt_pk_bf16(o0[2], o0[3]); w.z = cvt_pk_bf16(o1[0], o1[1]); w.w = cvt_pk_bf16(o1[2], o1[3]);
                    *(u32x4*)(Z + (size_t)row * ldz + u.pn * 128 + wc * 32 + 8 * fq) = w;
                }
            return;
        }
        u32x4 wa, wb; float s1, s2;
#define EPZ_COMP(g) { const int ai_ = (g) >> 2, m_ = (g) & 3; const float rs = rs8[g]; \
            const f32x4 v0 = acc[ai_][0][m_][0] * rs, v1 = acc[ai_][0][m_][1] * rs, v2 = acc[ai_][1][m_][0] * rs, v3 = acc[ai_][1][m_][1] * rs; \
            wa.x = cvt_pk_bf16(v0[0], v0[1]); wa.y = cvt_pk_bf16(v0[2], v0[3]); wa.z = cvt_pk_bf16(v1[0], v1[1]); wa.w = cvt_pk_bf16(v1[2], v1[3]); \
            wb.x = cvt_pk_bf16(v2[0], v2[1]); wb.y = cvt_pk_bf16(v2[2], v2[3]); wb.z = cvt_pk_bf16(v3[0], v3[1]); wb.w = cvt_pk_bf16(v3[2], v3[3]); \
            if (dost) { \
                s1 = ((v0[0] + v0[1]) + (v0[2] + v0[3]) + (v1[0] + v1[1]) + (v1[2] + v1[3])) + ((v2[0] + v2[1]) + (v2[2] + v2[3]) + (v3[0] + v3[1]) + (v3[2] + v3[3])); \
                s2 = ((v0[0] * v0[0] + v0[1] * v0[1]) + (v0[2] * v0[2] + v0[3] * v0[3]) + (v1[0] * v1[0] + v1[1] * v1[1]) + (v1[2] * v1[2] + v1[3] * v1[3])) \
                   + ((v2[0] * v2[0] + v2[1] * v2[1]) + (v2[2] * v2[2] + v2[3] * v2[3]) + (v3[0] * v3[0] + v3[1] * v3[1]) + (v3[2] * v3[2] + v3[3] * v3[3])); } }
        s1 = 0.f; s2 = 0.f;
        EPZ_COMP(0)
#pragma unroll
        for (int g = 0; g < 8; ++g) {
            const int row = row0 + (g >> 2) * HALF + (g & 3) * 16;
            *(PG8_LAS u32x4*)(slw) = wa; *(PG8_LAS u32x4*)(slw + 64) = wb;
            float t1 = s1, t2 = s2;
            const u32x4 ra = *(const PG8_LAS u32x4*)(slr), rb = *(const PG8_LAS u32x4*)(slr + 1152);
            if (g < 7) EPZ_COMP(g + 1)
            bf16_t* zp = Z + (size_t)(row + drow) * ldz + (u.pn * BM + wc * 64 - 128 * ug_tiles) + dcol;
            st_wt((u32x4*)zp, ra); st_wt((u32x4*)(zp + (size_t)8 * ldz), rb);
            if (dost) {
                t1 = rowsum4(t1); t2 = rowsum4(t2);
                if (fq == 0) { fx_add(st1 + row, t1); fx_add(st2 + row, t2); }
            }
        }
#undef EPZ_COMP
    }
};
struct EpiX {
    static constexpr bool PERM = true, AFTER_DRAIN = false;
    bf16_t* xb; unsigned long long* ssq_next; PG8_LAS unsigned char* slab0;
    __device__ __forceinline__ void operator()(const f32x4 (&acc)[2][2][4][2], const Unit& u, int ui, int wr, int wc, int fr, int fq) const {
        int ln_ = fr + 16 * fq; asm volatile("" : "+v"(ln_));
        PG8_LAS unsigned char* const slw = slab0 + (wr * 4 + wc) * 2304 + (ln_ & 15) * 144 + (ln_ >> 4) * 16;
        PG8_LAS unsigned char* const slr = slab0 + (wr * 4 + wc) * 2304 + (ln_ >> 3) * 144 + (ln_ & 7) * 16;
        const int drow = (ln_ >> 3) - (ln_ & 15), dcol = 8 * (ln_ & 7);
        const int row0 = u.pm * BM + wr * 64 + fr, col0 = u.pn * BM + wc * 64 + 8 * fq;
        u32x4 xa, xc, wa, wb; float s2;
#define EPX_LOAD(g) { const size_t off_ = (size_t)(row0 + ((g) >> 2) * HALF + ((g) & 3) * 16) * 2048 + col0; xa = *(const u32x4*)(xb + off_); xc = *(const u32x4*)(xb + off_ + 32); }
#define EPX_UP(w_) (f32x4){__uint_as_float((w_).x << 16), __uint_as_float((w_).x & 0xffff0000u), __uint_as_float((w_).y << 16), __uint_as_float((w_).y & 0xffff0000u)}
#define EPX_UQ(w_) (f32x4){__uint_as_float((w_).z << 16), __uint_as_float((w_).z & 0xffff0000u), __uint_as_float((w_).w << 16), __uint_as_float((w_).w & 0xffff0000u)}
#define EPX_COMP(g) { const int ai_ = (g) >> 2, m_ = (g) & 3; \
            const f32x4 v0 = acc[ai_][0][m_][0] + EPX_UP(xa), v1 = acc[ai_][0][m_][1] + EPX_UQ(xa), v2 = acc[ai_][1][m_][0] + EPX_UP(xc), v3 = acc[ai_][1][m_][1] + EPX_UQ(xc); \
            wa.x = cvt_pk_bf16(v0[0], v0[1]); wa.y = cvt_pk_bf16(v0[2], v0[3]); wa.z = cvt_pk_bf16(v1[0], v1[1]); wa.w = cvt_pk_bf16(v1[2], v1[3]); \
            wb.x = cvt_pk_bf16(v2[0], v2[1]); wb.y = cvt_pk_bf16(v2[2], v2[3]); wb.z = cvt_pk_bf16(v3[0], v3[1]); wb.w = cvt_pk_bf16(v3[2], v3[3]); \
              \
            const f32x4 r0 = EPX_UP(wa), r1 = EPX_UQ(wa), r2 = EPX_UP(wb), r3 = EPX_UQ(wb); \
            s2 = ((r0[0] * r0[0] + r0[1] * r0[1]) + (r0[2] * r0[2] + r0[3] * r0[3]) + (r1[0] * r1[0] + r1[1] * r1[1]) + (r1[2] * r1[2] + r1[3] * r1[3])) \
               + ((r2[0] * r2[0] + r2[1] * r2[1]) + (r2[2] * r2[2] + r2[3] * r2[3]) + (r3[0] * r3[0] + r3[1] * r3[1]) + (r3[2] * r3[2] + r3[3] * r3[3])); }
        EPX_LOAD(0)
        EPX_COMP(0)
        EPX_LOAD(1)
#pragma unroll
        for (int g = 0; g < 8; ++g) {
            const int row = row0 + (g >> 2) * HALF + (g & 3) * 16;
            *(PG8_LAS u32x4*)(slw) = wa; *(PG8_LAS u32x4*)(slw + 64) = wb;
            float t2 = s2;
            const u32x4 ra = *(const PG8_LAS u32x4*)(slr), rb = *(const PG8_LAS u32x4*)(slr + 1152);
            if (g < 7) EPX_COMP(g + 1)
            if (g < 6) EPX_LOAD(g + 2)
            bf16_t* zp = xb + (size_t)(row + drow) * 2048 + (u.pn * BM + wc * 64) + dcol;
            st_wt((u32x4*)zp, ra); st_wt((u32x4*)(zp + (size_t)8 * 2048), rb);
            t2 = rowsum4(t2);
            if (fq == 0) fx_add(ssq_next + row, t2);
        }
#undef EPX_LOAD
#undef EPX_UP
#undef EPX_UQ
#undef EPX_COMP
    }
};
template <class Epi, class Sched, bool ALIGN_EPI = false, bool SP2 = false>
__device__ __forceinline__ void gemm_phase(PG8_LAS unsigned char* lds, const Gemm g, const Sched& S, const Epi& E, const int tid) {
    const int wid = __builtin_amdgcn_readfirstlane(tid >> 6), lane = tid & 63, wr = wid >> 2, wc = wid & 3, fr = lane & 15, fq = lane >> 4;
    const int K = g.K, nt = K / BK;
    unsigned voffA[2], voffB[2];
#pragma unroll
    for (int i = 0; i < 2; ++i) { int R, C; stage_rc(tid * 16 + i * 8192, R, C); const int Rb = Epi::PERM ? ((R >> 5) * 64 + perm32(R & 31)) : R;
        voffA[i] = (unsigned)(R * K + C) * 2u; voffB[i] = (unsigned)(Rb * K + C) * 2u; }
    const size_t kstep = (size_t)(BK * 2);
    const size_t hstep = (size_t)HALF * K * 2;
    const size_t tstep = 2 * hstep; const size_t hstepB = Epi::PERM ? (size_t)32 * K * 2 : hstep;
    const unsigned ldsw = (unsigned)wid * 1024u;
    const int aoff = lds_byte(wr * 64 + fr, fq * 8), boff = lds_byte(wc * 32 + fr, fq * 8);
#define PG8_SA(b, h) (((b) * 2 + (h)) * HTB)
#define PG8_SB(b, h) ((4 + (b) * 2 + (h)) * HTB)
#define PG8_STAGE(bufoff, gbase, voff) do { _Pragma("unroll") for (int _i = 0; _i < 2; ++_i) \
        __builtin_amdgcn_global_load_lds((const unsigned*)((const char*)(gbase) + (voff)[_i]), (PG8_LAS unsigned*)(lds + (bufoff) + ldsw + _i * 8192), 16, 0, 0); } while (0)
#define PG8_LDA(dst, b, h) do { _Pragma("unroll") for (int m = 0; m < 4; ++m) _Pragma("unroll") for (int k = 0; k < 2; ++k) dst[m][k] = *(const PG8_LAS bf16x8*)(lds + PG8_SA(b, h) + aoff + m * 2048 + k * 1024); } while (0)
#define PG8_LDB(dst, b, h) do { _Pragma("unroll") for (int n = 0; n < 2; ++n) _Pragma("unroll") for (int k = 0; k < 2; ++k) dst[n][k] = *(const PG8_LAS bf16x8*)(lds + PG8_SB(b, h) + boff + n * 2048 + k * 1024); } while (0)
#define PG8_MMA(ai, bj, At, Bt) do { __builtin_amdgcn_s_setprio(1); _Pragma("unroll") for (int m = 0; m < 4; ++m) _Pragma("unroll") for (int n = 0; n < 2; ++n) _Pragma("unroll") for (int k = 0; k < 2; ++k) \
        acc[ai][bj][m][n] = __builtin_amdgcn_mfma_f32_16x16x32_bf16(Bt[n][k], At[m][k], acc[ai][bj][m][n], 0, 0, 0); __builtin_amdgcn_s_setprio(0); } while (0)
#define PG8_WAIT_V(n) asm volatile("s_waitcnt vmcnt(" #n ")" ::: "memory")
#define PG8_WAIT_L(n) asm volatile("s_waitcnt lgkmcnt(" #n ")" ::: "memory")
#define PG8_BAR __builtin_amdgcn_s_barrier()
#define PG8_SCHED __builtin_amdgcn_sched_barrier(0)
    Unit cur, nxt; int ui = 0;
    if (!S.next(0, cur)) return;
    f32x4 acc[2][2][4][2];
#pragma unroll
    for (int a = 0; a < 2; ++a)
#pragma unroll
        for (int b = 0; b < 2; ++b)
#pragma unroll
            for (int m = 0; m < 4; ++m)
#pragma unroll
                for (int n = 0; n < 2; ++n) acc[a][b][m][n] = (f32x4){0.f, 0.f, 0.f, 0.f};
    bf16x8 At[4][2], B0[2][2], B1[2][2];
    const char* cA = (const char*)g.A + (size_t)cur.pm * tstep; const char* cB = (const char*)g.Bt + (size_t)cur.pn * tstep;
    S.a_ready(cur);
    if constexpr (SP2) {
        PG8_STAGE(PG8_SB(0, 0), cB, voffB); PG8_STAGE(PG8_SB(0, 1), cB + hstepB, voffB); PG8_STAGE(PG8_SA(0, 0), cA, voffA); PG8_STAGE(PG8_SA(0, 1), cA + hstep, voffA);
        if (wr == 1) PG8_BAR;
        PG8_WAIT_V(2); PG8_BAR;
        PG8_STAGE(PG8_SB(1, 0), cB + kstep, voffB); PG8_STAGE(PG8_SA(1, 0), cA + kstep, voffA); PG8_STAGE(PG8_SB(1, 1), cB + hstepB + kstep, voffB);
        PG8_WAIT_V(6); PG8_BAR;
    } else {
        PG8_STAGE(PG8_SB(0, 0), cB, voffB); PG8_STAGE(PG8_SA(0, 0), cA, voffA); PG8_STAGE(PG8_SB(0, 1), cB + hstepB, voffB); PG8_STAGE(PG8_SA(0, 1), cA + hstep, voffA);
        if (wr == 1) PG8_BAR;
        PG8_WAIT_V(4); PG8_BAR;
        PG8_STAGE(PG8_SB(1, 0), cB + kstep, voffB); PG8_STAGE(PG8_SA(1, 0), cA + kstep, voffA); PG8_STAGE(PG8_SB(1, 1), cB + hstepB + kstep, voffB);
        PG8_WAIT_V(6); PG8_BAR;
    }
    for (;;) {
        const bool has_next = S.next(ui + 1, nxt);
        const char* nA = has_next ? (const char*)g.A + (size_t)nxt.pm * tstep : cA; const char* nB = has_next ? (const char*)g.Bt + (size_t)nxt.pn * tstep : cB;
        for (int t = 0; t < nt; t += 2) {
            const bool last = (t == nt - 2);
            const char* a1 = cA + (size_t)(t + 1) * kstep;
            const char* a2 = last ? nA : cA + (size_t)(t + 2) * kstep; const char* b2 = last ? nB : cB + (size_t)(t + 2) * kstep;
            const char* a3 = a2 + kstep; const char* b3 = b2 + kstep;
            if (last && has_next) S.a_ready(nxt);
            if constexpr (SP2) {
            PG8_LDB(B0, 0, 0); PG8_LDB(B1, 0, 1); PG8_SCHED; PG8_LDA(At, 0, 0); PG8_STAGE(PG8_SA(1, 1), a1 + hstep, voffA);
            PG8_WAIT_V(8); PG8_WAIT_L(0); PG8_BAR; PG8_MMA(0, 0, At, B0); PG8_MMA(0, 1, At, B1); PG8_BAR; PG8_SCHED;
            PG8_LDA(At, 0, 1); PG8_STAGE(PG8_SB(0, 0), b2, voffB); PG8_STAGE(PG8_SB(0, 1), b2 + hstepB, voffB); PG8_STAGE(PG8_SA(0, 0), a2, voffA);
            PG8_WAIT_V(8); PG8_WAIT_L(0); PG8_BAR; PG8_MMA(1, 0, At, B0); PG8_MMA(1, 1, At, B1); PG8_BAR; PG8_SCHED;
            PG8_LDB(B0, 1, 0); PG8_LDB(B1, 1, 1); PG8_SCHED; PG8_LDA(At, 1, 0); PG8_STAGE(PG8_SA(0, 1), a2 + hstep, voffA);
            PG8_WAIT_V(8); PG8_WAIT_L(0); PG8_BAR; PG8_MMA(0, 0, At, B0); PG8_MMA(0, 1, At, B1); PG8_BAR; PG8_SCHED;
            PG8_LDA(At, 1, 1); PG8_STAGE(PG8_SB(1, 0), b3, voffB); PG8_STAGE(PG8_SB(1, 1), b3 + hstepB, voffB); PG8_STAGE(PG8_SA(1, 0), a3, voffA);
            PG8_WAIT_V(8); PG8_WAIT_L(0); PG8_BAR; PG8_MMA(1, 0, At, B0); PG8_MMA(1, 1, At, B1); PG8_BAR; PG8_SCHED;
            } else {
            PG8_LDB(B0, 0, 0); PG8_SCHED; PG8_LDA(At, 0, 0); PG8_STAGE(PG8_SA(1, 1), a1 + hstep, voffA);
            PG8_WAIT_L(8); PG8_BAR; PG8_WAIT_L(0); PG8_MMA(0, 0, At, B0); PG8_BAR; PG8_SCHED;
            PG8_LDB(B1, 0, 1); PG8_STAGE(PG8_SB(0, 0), b2, voffB);
            PG8_BAR; PG8_WAIT_L(0); PG8_MMA(0, 1, At, B1); PG8_BAR;
            PG8_LDA(At, 0, 1); PG8_STAGE(PG8_SA(0, 0), a2, voffA);
            PG8_BAR; PG8_WAIT_L(0); PG8_MMA(1, 0, At, B0); PG8_BAR; PG8_SCHED;
            PG8_STAGE(PG8_SB(0, 1), b2 + hstepB, voffB);
            PG8_WAIT_V(6); PG8_BAR; PG8_MMA(1, 1, At, B1); PG8_BAR;
            PG8_LDB(B0, 1, 0); PG8_SCHED; PG8_LDA(At, 1, 0); PG8_STAGE(PG8_SA(0, 1), a2 + hstep, voffA);
            PG8_WAIT_L(8); PG8_BAR; PG8_WAIT_L(0); PG8_MMA(0, 0, At, B0); PG8_BAR; PG8_SCHED;
            PG8_LDB(B1, 1, 1); PG8_STAGE(PG8_SB(1, 0), b3, voffB);
            PG8_BAR; PG8_WAIT_L(0); PG8_MMA(0, 1, At, B1); PG8_BAR;
            PG8_LDA(At, 1, 1); PG8_STAGE(PG8_SA(1, 0), a3, voffA);
            PG8_BAR; PG8_WAIT_L(0); PG8_MMA(1, 0, At, B0); PG8_BAR; PG8_SCHED;
            PG8_STAGE(PG8_SB(1, 1), b3 + hstepB, voffB);
            PG8_WAIT_V(6); PG8_BAR; PG8_MMA(1, 1, At, B1); PG8_BAR;
            }
        }
        if constexpr (ALIGN_EPI) { if (wr == 0) PG8_BAR; }
        if constexpr (!Epi::AFTER_DRAIN) { E(acc, cur, ui, wr, wc, fr, fq); S.done(cur); }
        if (!has_next) break;
#pragma unroll
        for (int a = 0; a < 2; ++a)
#pragma unroll
            for (int b = 0; b < 2; ++b)
#pragma unroll
                for (int m = 0; m < 4; ++m)
#pragma unroll
                    for (int n = 0; n < 2; ++n) acc[a][b][m][n] = (f32x4){0.f, 0.f, 0.f, 0.f};
        cur = nxt; cA = nA; cB = nB; ++ui;
        if constexpr (ALIGN_EPI) { if (wr == 1) PG8_BAR; }
    }
    PG8_WAIT_V(0);
    if constexpr (!ALIGN_EPI) { if (wr == 0) PG8_BAR; }
    PG8_BAR;
    if constexpr (Epi::AFTER_DRAIN) { E.fused(acc, cur, wr, wc, fr, fq, lds, wid, lane); S.done(cur); }
#undef PG8_SA
#undef PG8_SB
#undef PG8_STAGE
#undef PG8_LDA
#undef PG8_LDB
#undef PG8_MMA
#undef PG8_WAIT_V
#undef PG8_WAIT_L
#undef PG8_BAR
#undef PG8_SCHED
}
}

#ifndef PG8_SP2
#define PG8_SP2 true
#endif
#ifndef PG8_ALIGN
#define PG8_ALIGN true
#endif

constexpr int BATCH = 2, SEQ = 8192, DM = 2048, M = BATCH * SEQ;
constexpr int ZE = 6912, ZO = 6144, ECOLS = 6784, OCOLS = 6144;
constexpr int N_PHASES = 16;
constexpr unsigned long long PH_TYPE = 0x5431432143143210ull, PH_LAYER = 0x0333222211100000ull;
constexpr int ZC_XW = 4096, ZC_XA = 4160, ZC_E1 = 4224, ZC_E2 = 4256, ZC_Q = 4352, ZC_KB = 5376, ZC_VB = 5632, ZC_BG = 5888;
constexpr int ZO2 = 4096;

constexpr size_t MiB = 1u << 20;
constexpr size_t WS_CTL = 0, CTL_ZERO_BYTES = 1 * MiB;
constexpr size_t WS_STAT = 1 * MiB;
constexpr size_t WS_ROPE = 3 * MiB;
constexpr size_t WS_WEIN = 4 * MiB;
constexpr size_t WS_WOIN = 31 * MiB;
constexpr size_t WS_WEOUT = 55 * MiB;
constexpr size_t WS_WOOUT = 71 * MiB;
constexpr size_t WS_XB = 87 * MiB;
constexpr size_t WS_Y = 151 * MiB;
constexpr size_t WS_VF = 215 * MiB;
constexpr size_t WS_Z = 247 * MiB;
constexpr size_t WS_END = 463 * MiB;
constexpr int CW_BAR = 4096;

constexpr int RING_OFF = 0, RING_BYTES = 131072;
constexpr int RST_OFF = 131072, RST_UNITS = 8;
constexpr int LDSCTL_OFF = 162816, MISC_OFF = LDSCTL_OFF + 320;
constexpr int LDS_BYTES = 163840;
constexpr int NWAVES = 8;
#define GAS __attribute__((address_space(1)))
#define LAS __attribute__((address_space(3)))
typedef unsigned short bf16;
typedef unsigned v4u __attribute__((ext_vector_type(4)));
typedef float f32x4 __attribute__((ext_vector_type(4)));
typedef short bf16x8 __attribute__((ext_vector_type(8)));
typedef GAS unsigned gu32;
typedef GAS unsigned long long gu64;
#define RLX_AGENT __ATOMIC_RELAXED, __HIP_MEMORY_SCOPE_AGENT
#define LDS_WAIT() asm volatile("s_waitcnt lgkmcnt(0)" ::: "memory")
#define VM_WAIT() asm volatile("s_waitcnt vmcnt(0)" ::: "memory")
__device__ __forceinline__ unsigned long long rt() { return __builtin_amdgcn_s_memrealtime(); }
__device__ __forceinline__ unsigned f2bf(float f) { unsigned u = __builtin_bit_cast(unsigned, f); return (u + 0x7fffu + ((u >> 16) & 1u)) >> 16; }
__device__ __forceinline__ unsigned pk2(float lo, float hi) { return f2bf(lo) | (f2bf(hi) << 16); }

#define XB_TMO      128
#define XB_XCNT(j)  (256  + 64 * (j))
#define XB_XSUB(j)  (1280 + 64 * (j))
#define XB_XGEN(j)  (2304 + 64 * (j))
#define XB_TOP      3328
#define XB_TOPGEN   3392
#define XCD_BAR_WORDS 3456
#define XB_SPIN_CAP (1u << 18)

__device__ __forceinline__ unsigned xb_ld(unsigned* p)              { return __hip_atomic_load(p, __ATOMIC_RELAXED, __HIP_MEMORY_SCOPE_AGENT); }
__device__ __forceinline__ unsigned xb_add(unsigned* p, unsigned v) { return __hip_atomic_fetch_add(p, v, __ATOMIC_RELAXED, __HIP_MEMORY_SCOPE_AGENT); }
__device__ __forceinline__ unsigned xb_xcc_id() { return (unsigned)__builtin_amdgcn_s_getreg((3 << 11) | 20) & 0xFu; }
#define XB_SPIN(cond, bar) do { unsigned _sp = 0; while (cond) { __builtin_amdgcn_s_sleep(1); \
    if ((++_sp & 255u) == 0u) { if (xb_ld(&(bar)[XB_TMO])) break; if (_sp > XB_SPIN_CAP) { atomicAdd(&(bar)[XB_TMO], 1u); break; } } } } while (0)

struct XcdBarrier {
    unsigned* bar; unsigned x;
    volatile LAS unsigned* st;
};

__device__ __forceinline__ XcdBarrier xcd_barrier_post(unsigned* bar, volatile LAS unsigned* st) {
    XcdBarrier b; b.bar = bar; b.x = xb_xcc_id(); b.st = st;
    if (threadIdx.x == 0) (void)xb_add(&bar[XB_XCNT(b.x)], 1u);
    return b;
}
__device__ __forceinline__ void xcd_barrier_complete(unsigned* bar, unsigned x, unsigned& nloc, unsigned& nx) {
    const unsigned G = gridDim.x * gridDim.y * gridDim.z;
    unsigned sum, cnt, mine, sp = 0u;
    for (;;) {
        sum = 0u; cnt = 0u; mine = 0u;
#pragma unroll
        for (unsigned j = 0; j < 16; ++j) { const unsigned c = xb_ld(&bar[XB_XCNT(j)]); sum += c; cnt += (c > 0u) ? 1u : 0u; mine = (j == x) ? c : mine; }
        if (sum == G) break;
        __builtin_amdgcn_s_sleep(1);
        if ((++sp & 255u) == 0u) { if (xb_ld(&bar[XB_TMO])) break; if (sp > XB_SPIN_CAP) { atomicAdd(&bar[XB_TMO], 1u); break; } }
    }
    nloc = mine > 0u ? mine : 1u; nx = cnt > 0u ? cnt : 1u;
}

__device__ __forceinline__ void xcd_barrier(const XcdBarrier& b, const int tid) {
    asm volatile("s_waitcnt vmcnt(0)" ::: "memory");
    __syncthreads();
    if (tid == 0) {
        unsigned* bar = b.bar;
        __builtin_amdgcn_s_waitcnt(0);
        unsigned nloc = b.st[0], nx = b.st[1];
        if (nloc == 0u) { xcd_barrier_complete(bar, b.x, nloc, nx); b.st[0] = nloc; b.st[1] = nx; }
        const unsigned old = xb_add(&bar[XB_XSUB(b.x)], 1u);
        const unsigned gen = old / nloc;
        if (old + 1u == (gen + 1u) * nloc) {
            __builtin_amdgcn_fence(__ATOMIC_RELEASE, "agent");
            asm volatile("s_waitcnt vmcnt(0)" ::: "memory");
            const unsigned og = xb_add(&bar[XB_TOP], 1u);
            const unsigned tg = og / nx;
            if (og + 1u == (tg + 1u) * nx) xb_add(&bar[XB_TOPGEN], 1u);
            else XB_SPIN(xb_ld(&bar[XB_TOPGEN]) == tg, bar);
            __builtin_amdgcn_fence(__ATOMIC_ACQUIRE, "agent");
            xb_add(&bar[XB_XGEN(b.x)], 1u);
            asm volatile("s_waitcnt vmcnt(0)" ::: "memory");
        } else {
            XB_SPIN(xb_ld(&bar[XB_XGEN(b.x)]) == gen, bar);
            __builtin_amdgcn_fence(__ATOMIC_ACQUIRE, "agent");
            asm volatile("s_waitcnt vmcnt(0)" ::: "memory");
        }
    }
    __syncthreads();
}

typedef float f32x2 __attribute__((ext_vector_type(2)));
typedef unsigned u32x2 __attribute__((ext_vector_type(2)));
__device__ __forceinline__ float bflo(unsigned w) { return __uint_as_float(w << 16); }
__device__ __forceinline__ float bfhi(unsigned w) { return __uint_as_float(w & 0xffff0000u); }
__device__ __forceinline__ float bf2f(bf16 b) { return __uint_as_float((unsigned)b << 16); }
typedef __bf16 bf16x2_t __attribute__((ext_vector_type(2)));
__device__ __forceinline__ unsigned pkbf(float lo, float hi) { const f32x2 v = {lo, hi}; const bf16x2_t b = __builtin_convertvector(v, bf16x2_t); return __builtin_bit_cast(unsigned, b); }
template <int CTRL> __device__ __forceinline__ float dppf(float x) { return __int_as_float(__builtin_amdgcn_update_dpp(0, __float_as_int(x), CTRL, 0xF, 0xF, true)); }
#define DPP_XOR1 0xB1
#define DPP_XOR2 0x4E
#define DPP_HMIRROR 0x141
#define DPP_MIRROR 0x140
__device__ __forceinline__ float red4(float s) { s += dppf<DPP_XOR1>(s); s += dppf<DPP_XOR2>(s); return s; }
__device__ __forceinline__ float red8(float s) { s = red4(s); s += dppf<DPP_HMIRROR>(s); return s; }
__device__ __forceinline__ float red16(float s) { s = red8(s); s += dppf<DPP_MIRROR>(s); return s; }
__device__ __forceinline__ float max4(float s) { s = fmaxf(s, dppf<DPP_XOR1>(s)); s = fmaxf(s, dppf<DPP_XOR2>(s)); return s; }
__device__ __forceinline__ float wave_sum(float v) {
#pragma unroll
    for (int o = 1; o < 64; o <<= 1) v += __shfl_xor(v, o);
    return v;
}
__device__ __forceinline__ float fexp(float x) { return __builtin_amdgcn_exp2f(x * 1.4426950408889634f); }
__device__ __forceinline__ float flog(float x) { return __builtin_amdgcn_logf(x) * 0.6931471805599453f; }
__device__ __forceinline__ float sigmoidf_(float x) { return __builtin_amdgcn_rcpf(1.0f + fexp(-x)); }
__device__ __forceinline__ float siluf_(float x) { return x * __builtin_amdgcn_rcpf(1.0f + fexp(-x)); }

__device__ __forceinline__ int emap(int c) {
    if (c < 3072) { const int seg = c >> 10, cc = c & 1023; return (cc >> 6) * 256 + seg * 64 + (cc & 63); }
    if (c < 3136) return ZC_XW + (c - 3072);
    if (c < 3200) return ZC_XA + (c - 3136);
    if (c < 4224) { const int cc = c - 3200; return (cc >> 6) * 256 + 192 + (cc & 63); }
    if (c < 5248) return ZC_Q + (c - 4224);
    if (c < 5504) return ZC_KB + (c - 5248);
    if (c < 5760) return ZC_VB + (c - 5504);
    return ZC_BG + (c - 5760);
}
__device__ __forceinline__ int omap(int c) { if (c < 2048) return (c >> 7) * 256 + ((c >> 5) & 3) * 64 + (c & 31); if (c >= 4096) { const int ch = c - 4096; return (ch >> 7) * 256 + ((ch >> 5) & 3) * 64 + 32 + (ch & 31); } return 4096 + (c - 2048); }
__device__ __forceinline__ void conv_weight(const float* W, int Nsrc, const float* g, bf16* WT, int mapkind  , LAS float* scr, int gw, int NGW, int lane) {
    const int nblk = Nsrc / 64, nitems = 32 * nblk;
    const int lq = lane >> 4, l4 = 4 * (lane & 15);
    for (int it = gw; it < nitems; it += NGW) {
        const int kb = it / nblk, nb = it % nblk, k0 = 64 * kb, n0 = 64 * nb;
        const int drow = (mapkind == 1) ? emap(n0) : (mapkind == 2) ? omap(n0) : n0;
        const int drow_hi = (mapkind == 2) ? omap(n0 + 32) : drow + 32;
        f32x4 v[16];
#pragma unroll
        for (int i = 0; i < 16; ++i) v[i] = *(const f32x4*)(W + (size_t)(k0 + 4 * i + lq) * Nsrc + n0 + l4);
        if (g) {
            float gv[16];
#pragma unroll
            for (int i = 0; i < 16; ++i) gv[i] = g[k0 + 4 * i + lq];
            asm volatile("s_waitcnt vmcnt(0)" ::: "memory");
#pragma unroll
            for (int i = 0; i < 16; ++i) v[i] = v[i] * gv[i];
        }
#pragma unroll
        for (int i = 0; i < 16; ++i) { LAS float* d = scr + (4 * i + lq) * 65 + l4; d[0] = v[i][0]; d[1] = v[i][1]; d[2] = v[i][2]; d[3] = v[i][3]; }
        LDS_WAIT(); asm volatile("" ::: "memory");
        const int c = lane & 7;
#pragma unroll
        for (int j = 0; j < 8; ++j) { const int n = (lane >> 3) + 8 * j; const LAS float* s = scr + (8 * c) * 65 + n;
            v4u o; o.x = pkbf(s[0 * 65], s[1 * 65]); o.y = pkbf(s[2 * 65], s[3 * 65]); o.z = pkbf(s[4 * 65], s[5 * 65]); o.w = pkbf(s[6 * 65], s[7 * 65]);
            *(GAS v4u*)(WT + (size_t)((j < 4 ? drow : drow_hi) + (n & 31)) * 2048 + k0 + 8 * c) = o; }
        LDS_WAIT(); asm volatile("" ::: "memory");
    }
}
__device__ __forceinline__ void zero_rows(bf16* WT, int r0, int r1, int gtid, int NGT) {
    const size_t n16 = (size_t)(r1 - r0) * 2048 / 8;
    GAS v4u* p = (GAS v4u*)(WT + (size_t)r0 * 2048);
    for (size_t i = gtid; i < n16; i += NGT) p[i] = (v4u){0u, 0u, 0u, 0u};
}

struct RwkvP { const float *mu, *w0, *w2, *a0, *a2, *kk, *ka, *rk, *lnw, *lnb, *v0, *v2; int e; };

typedef short bf16x8 __attribute__((ext_vector_type(8)));
#define MFMA16(a, b, c) __builtin_amdgcn_mfma_f32_16x16x32_bf16((a), (b), (c), 0, 0, 0)
__device__ __forceinline__ bf16x8 ldfrag(const LAS bf16* p, int ld, int lane) { return *(const LAS bf16x8*)(p + (lane & 15) * ld + 8 * (lane >> 4)); }
__device__ __forceinline__ bf16x8 ldfrag16(const LAS bf16* p, int ld, int lane) { const bf16x8 z = {0, 0, 0, 0, 0, 0, 0, 0}; const bf16x8 f = *(const LAS bf16x8*)(p + (lane & 15) * ld + 8 * ((lane >> 4) & 1)); return (lane < 32) ? f : z; }
__device__ __forceinline__ void st_nat(LAS bf16* out, int ld, int m0, int lane, const f32x4 acc) { u32x2 w; w.x = pkbf(acc[0], acc[1]); w.y = pkbf(acc[2], acc[3]); *(LAS u32x2*)(out + (lane & 15) * ld + m0 + 4 * (lane >> 4)) = w; }

__device__ __forceinline__ bf16x8 ldfo(const LAS bf16* p, int off) { return *(const LAS bf16x8*)(p + off); }
__device__ __forceinline__ void st_no(LAS bf16* out, int off, const f32x4 acc) { u32x2 w; w.x = pkbf(acc[0], acc[1]); w.y = pkbf(acc[2], acc[3]); *(LAS u32x2*)(out + off) = w; }
constexpr int R2_S72 = 72, R2_S40 = 40;
constexpr int R2_W2T = 0, R2_A2T = 9216, R2_V2T = 18432, R2_SB0 = 23552, R2_SB1 = 32768, R2_TXW = 41984, R2_XA = 46592, R2_EE = 51200,
              R2_F68 = 68,
              R2_LCUM = 53760, R2_LAF = 62464, R2_LVF = 71168, R2_GC = 79872,
              R2_AH = 80128, R2_BH = 84736, R2_KH = 89344, R2_RH = 93952,
              R2_BGT = 98560, R2_KGT = 103936, R2_VT = 109312,
              R2_LAB = R2_TXW, R2_LAK = R2_TXW + 4096, R2_QRB = R2_TXW + 6656, R2_QRK = R2_TXW + 9216,
              R2_DM = R2_LCUM, R2_DTM = R2_LCUM + 2560, R2_MT = R2_LCUM + 5120,
              R2_TM = R2_LVF, R2_W1T = R2_LVF + 2560,
              R2_RHX = 117504, R2_UT = 122624, R2_BON = 127744, R2_UXT = 127872, R2_XB0 = 132992, R2_XB1 = 142208, R2_PAR = 151424, R2_END = 154496;
static_assert(R2_QRK + 2560 <= R2_LCUM && R2_MT + 2560 <= R2_LAF && R2_W1T + 5120 <= R2_GC && R2_VT + 5376 <= R2_RHX && R2_END <= 162816, "rwkv_v2 LDS map");
__device__ __forceinline__ int r2_sk(int r) { return r * R2_S40 + (r >> 2) * 8; }
typedef short r2_s16x4 __attribute__((ext_vector_type(4)));
__device__ __forceinline__ bf16x8 r2_trf(const LAS bf16* img, int tokA, int tokB, int c0, int n) {
    const LAS bf16* p = img + (n >> 2) * R2_S72 + c0 + 4 * (n & 3);
    const r2_s16x4 a = __builtin_bit_cast(r2_s16x4, __builtin_amdgcn_ds_read_tr16_b64_v4i16((LAS r2_s16x4*)(p + tokA * R2_S72)));
    const r2_s16x4 b = __builtin_bit_cast(r2_s16x4, __builtin_amdgcn_ds_read_tr16_b64_v4i16((LAS r2_s16x4*)(p + tokB * R2_S72)));
    return (bf16x8){a[0], a[1], a[2], a[3], b[0], b[1], b[2], b[3]};
}
__device__ __forceinline__ bf16x8 ldfrag_sk(const LAS bf16* base, int row0, int lane) { const int r = row0 + (lane & 15); return *(const LAS bf16x8*)(base + r2_sk(r) + 8 * (lane >> 4)); }

__device__ __forceinline__ void rwkv_v2(LAS unsigned char* lds, const RwkvP P, int b, int h, int seg, int mode, const bf16* Z, bf16* Y, bf16* VF, float* MG, unsigned char* CACHE, const int tid, const int wave) {
    LAS bf16* W2T = (LAS bf16*)(lds + R2_W2T); LAS bf16* A2T = (LAS bf16*)(lds + R2_A2T); LAS bf16* V2T = (LAS bf16*)(lds + R2_V2T);
    LAS bf16* TXW = (LAS bf16*)(lds + R2_TXW); LAS bf16* XAS = (LAS bf16*)(lds + R2_XA); LAS bf16* EES = (LAS bf16*)(lds + R2_EE);
    LAS float* LCUM = (LAS float*)(lds + R2_LCUM); LAS float* LAF = (LAS float*)(lds + R2_LAF); LAS float* LVF = (LAS float*)(lds + R2_LVF); LAS float* GC = (LAS float*)(lds + R2_GC);
    LAS float* YS = LAF;
    LAS bf16* AH = (LAS bf16*)(lds + R2_AH); LAS bf16* BH = (LAS bf16*)(lds + R2_BH); LAS bf16* KH = (LAS bf16*)(lds + R2_KH); LAS bf16* RH = (LAS bf16*)(lds + R2_RH);
    LAS bf16* BGT = (LAS bf16*)(lds + R2_BGT); LAS bf16* KGT = (LAS bf16*)(lds + R2_KGT); LAS bf16* VT = (LAS bf16*)(lds + R2_VT);
    LAS float* LAB = (LAS float*)(lds + R2_LAB); LAS bf16* LAK = (LAS bf16*)(lds + R2_LAK); LAS bf16* QRB = (LAS bf16*)(lds + R2_QRB); LAS bf16* QRK = (LAS bf16*)(lds + R2_QRK);
    LAS bf16* DM = (LAS bf16*)(lds + R2_DM); LAS bf16* DTM = (LAS bf16*)(lds + R2_DTM); LAS bf16* MT = (LAS bf16*)(lds + R2_MT); LAS bf16* TM = (LAS bf16*)(lds + R2_TM);
    LAS bf16* W1T = (LAS bf16*)(lds + R2_W1T); LAS bf16* RHX = (LAS bf16*)(lds + R2_RHX); LAS bf16* UT = (LAS bf16*)(lds + R2_UT); LAS float* BON = (LAS float*)(lds + R2_BON); LAS bf16* UXT = (LAS bf16*)(lds + R2_UXT);
    const int e = P.e, hc = h * 64, lane0 = tid & 63;
    u32x2 pf_r, pf_k, pf_v, pf_w, pf_a, pf_g, pf_pr = {0u, 0u}, pf_pk = {0u, 0u}, pf_pv = {0u, 0u}, pf_pw = {0u, 0u}, pf_pa = {0u, 0u}, pf_vf = {0u, 0u}, pf_e1 = {0u, 0u}, pf_e2 = {0u, 0u};
    {
        const int c4 = 4 * (lane0 & 15), cg = lane0 & 15; const int t = seg * 1024 + wave * 4 + (lane0 >> 4); const size_t m = (size_t)b * SEQ + t;
        const bf16* zn = Z + m * ZE; const bf16* zq = zn - ZE; const bool hp = t > 0;
        pf_r = *(const u32x2*)(zn + h * 256 + c4); pf_k = *(const u32x2*)(zn + h * 256 + 64 + c4); pf_v = *(const u32x2*)(zn + h * 256 + 128 + c4); pf_g = *(const u32x2*)(zn + h * 256 + 192 + c4);
        pf_w = *(const u32x2*)(zn + ZC_XW + c4); pf_a = *(const u32x2*)(zn + ZC_XA + c4);
        if (hp) { pf_pr = *(const u32x2*)(zq + h * 256 + c4); pf_pk = *(const u32x2*)(zq + h * 256 + 64 + c4); pf_pv = *(const u32x2*)(zq + h * 256 + 128 + c4); pf_pw = *(const u32x2*)(zq + ZC_XW + c4); pf_pa = *(const u32x2*)(zq + ZC_XA + c4); }
        if (e > 0) { pf_vf = *(const u32x2*)(VF + m * 1024 + hc + c4); if (cg < 8) { pf_e1 = *(const u32x2*)(zn + ZC_E1 + c4); if (hp) pf_e2 = *(const u32x2*)(zq + ZC_E2 + c4); } }
    }
#define R2_BAR() asm volatile("s_waitcnt lgkmcnt(0)\n\ts_barrier" ::: "memory")
#define R2_FOFF() const int F72 = n * R2_S72 + 8 * q, F40 = n * R2_S40 + 8 * q, FSK = r2_sk(n) + 8 * q, N72 = n * R2_S72 + 4 * q, N40 = n * R2_S40 + 4 * q; (void)F72; (void)F40; (void)FSK; (void)N72; (void)N40
#define R2_LANEC() const int lane = lid_; const int q = lane >> 4, n = lane & 15, tk = wave * 4 + q, cg = n, c4 = 4 * n; (void)q; (void)n; (void)tk; (void)cg; (void)c4
#define R2_LANE() int lane = lane0; asm volatile("" : "+v"(lane)); const int q = lane >> 4, n = lane & 15, tk = wave * 4 + q, cg = n, c4 = 4 * n; (void)q; (void)n; (void)tk; (void)cg; (void)c4
    float w2r[8], a2r[8], v2r[4] = {0.f, 0.f, 0.f, 0.f}, parr[12];
#pragma unroll
    for (int i = 0; i < 8; ++i) { const int ii = tid + 512 * i, j = ii >> 6, c = ii & 63; w2r[i] = P.w2[(size_t)j * 1024 + hc + c]; a2r[i] = P.a2[(size_t)j * 1024 + hc + c]; }
    if (e > 0) {
#pragma unroll
        for (int i = 0; i < 4; ++i) { const int ii = tid + 512 * i, j = ii >> 6, c = ii & 63; v2r[i] = P.v2[(size_t)j * 1024 + hc + c]; } }
    { const int c = lane0;
      parr[0] = P.mu[hc + c]; parr[1] = P.mu[1024 + hc + c]; parr[2] = P.mu[2048 + hc + c]; parr[3] = P.mu[3072 + c]; parr[4] = P.mu[3136 + c];
      parr[5] = P.a0[hc + c]; parr[6] = P.kk[hc + c]; parr[7] = P.ka[hc + c]; parr[8] = P.rk[hc + c]; parr[9] = P.lnw[hc + c]; parr[10] = P.lnb[hc + c]; parr[11] = e > 0 ? P.v0[hc + c] : 0.f; }
    const f32x4 w0v = *(const f32x4*)(P.w0 + hc + 16 * (wave & 3) + 4 * (lane0 >> 4));
    f32x4 accS[2] = {{0.f, 0.f, 0.f, 0.f}, {0.f, 0.f, 0.f, 0.f}};
    f32x4 mr0 = {0.f, 0.f, 0.f, 0.f}, mr1 = mr0, gk[2] = {mr0, mr0};
    if (mode == 1 && seg > 0) {
        const float* MG0 = MG + (size_t)((b * 16 + h) * 8) * 8192; const int q_ = lane0 >> 4, n_ = lane0 & 15, ct_ = wave >> 1, vt0 = 2 * (wave & 1);
#pragma unroll
        for (int vi = 0; vi < 2; ++vi)
#pragma unroll
            for (int r = 0; r < 4; ++r) accS[vi][r] = MG0[4096 + (16 * (2 * (wave & 1) + vi) + 4 * q_ + r) * 64 + 16 * (wave >> 1) + n_];
        if (seg > 1) { const float* Mk = MG0 + 8192; mr0 = *(const f32x4*)(Mk + 8 * tid); mr1 = *(const f32x4*)(Mk + 8 * tid + 4);
#pragma unroll
            for (int vi = 0; vi < 2; ++vi)
#pragma unroll
                for (int r = 0; r < 4; ++r) gk[vi][r] = Mk[4096 + (16 * (2 * (wave & 1) + vi) + 4 * q_ + r) * 64 + 16 * (wave >> 1) + n_]; }
    }
#pragma unroll
    for (int i = 0; i < 8; ++i) { const int ii = tid + 512 * i, j = ii >> 6, c = ii & 63; W2T[c * R2_S72 + j] = (bf16)f2bf(w2r[i]); A2T[c * R2_S72 + j] = (bf16)f2bf(a2r[i]); }
    if (e > 0) {
#pragma unroll
        for (int i = 0; i < 4; ++i) { const int ii = tid + 512 * i, j = ii >> 6, c = ii & 63; V2T[c * R2_S40 + j] = (bf16)f2bf(v2r[i]); } }
    for (int i = tid; i < 2 * 9216 / 4; i += 512) ((LAS unsigned*)(lds + R2_SB0))[i] = 0u;
    LAS float* PAR = (LAS float*)(lds + R2_PAR);
    if (tid < 64) {
#pragma unroll
        for (int i = 0; i < 12; ++i) PAR[i * 64 + tid] = parr[i]; }
    f32x4 accX[2] = {{0.f, 0.f, 0.f, 0.f}, {0.f, 0.f, 0.f, 0.f}};
    float* MGu = MG + (size_t)((b * 16 + h) * 8 + seg) * 8192;
    unsigned char* CAu = CACHE + (size_t)((b * 16 + h) * 8 + seg) * 32 * 10240;
    LAS unsigned char* TMC = lds + R2_UXT;
    if (mode == 0) {
        for (int i = tid; i < 2 * 9216 / 4; i += 512) ((LAS unsigned*)(lds + R2_XB0))[i] = 0u;
        __syncthreads();
        if (tid < 64) ((LAS bf16*)(lds + R2_XB0))[tid * R2_S72 + tid] = (bf16)0x3F80;
        { const int q_ = lane0 >> 4, n_ = lane0 & 15, ct_ = wave >> 1;
#pragma unroll
          for (int vi = 0; vi < 2; ++vi)
#pragma unroll
              for (int r = 0; r < 4; ++r) accX[vi][r] = (16 * ct_ + 4 * q_ + r == 16 * (2 * (wave & 1) + vi) + n_) ? 1.f : 0.f; }
    } else if (seg > 0) {
        const float* MG0 = MG + (size_t)((b * 16 + h) * 8) * 8192;
        LAS bf16* MB = (LAS bf16*)(lds + R2_TXW);
        const int q_ = lane0 >> 4, n_ = lane0 & 15, ct_ = wave >> 1, vt0 = 2 * (wave & 1);
        int cur = (seg - 1) & 1;
        __syncthreads();
#pragma unroll
        for (int vi = 0; vi < 2; ++vi) st_nat((LAS bf16*)(lds + (cur ? R2_SB1 : R2_SB0)) + 16 * (wave >> 1) * R2_S72, R2_S72, 16 * (2 * (wave & 1) + vi), lane0, accS[vi]);
        for (int k = 1; k < seg; ++k) {
            *(LAS v4u*)(MB + (tid >> 3) * R2_S72 + 8 * (tid & 7)) = (v4u){pkbf(mr0[0], mr0[1]), pkbf(mr0[2], mr0[3]), pkbf(mr1[0], mr1[1]), pkbf(mr1[2], mr1[3])};
            f32x4 an[2] = {gk[0], gk[1]};
            if (k + 1 < seg) { const float* Mk = MG0 + (size_t)(k + 1) * 8192; mr0 = *(const f32x4*)(Mk + 8 * tid); mr1 = *(const f32x4*)(Mk + 8 * tid + 4);
#pragma unroll
                for (int vi = 0; vi < 2; ++vi)
#pragma unroll
                    for (int r = 0; r < 4; ++r) gk[vi][r] = Mk[4096 + (16 * (2 * (wave & 1) + vi) + 4 * q_ + r) * 64 + 16 * (wave >> 1) + n_]; }
            R2_BAR();
            const LAS bf16* Ti = (const LAS bf16*)(lds + (cur ? R2_SB1 : R2_SB0)); LAS bf16* To = (LAS bf16*)(lds + (cur ? R2_SB0 : R2_SB1));
#pragma unroll
            for (int vi = 0; vi < 2; ++vi) {
#pragma unroll
                for (int ks = 0; ks < 2; ++ks) an[vi] = MFMA16(ldfrag(MB + 16 * (2 * (wave & 1) + vi) * R2_S72 + 32 * ks, R2_S72, lane0), ldfrag(Ti + 16 * (wave >> 1) * R2_S72 + 32 * ks, R2_S72, lane0), an[vi]);
                accS[vi] = an[vi];
                st_nat(To + 16 * (wave >> 1) * R2_S72, R2_S72, 16 * (2 * (wave & 1) + vi), lane0, an[vi]);
            }
            cur ^= 1;
            R2_BAR();
        }
    }
    int sbuf = 0;
    const int tend = seg * 1024 + 1024;
    __syncthreads();
    for (int t0 = seg * 1024; t0 < seg * 1024 + 1024; t0 += 32) {
        int lid_ = lane0; asm volatile("" : "+v"(lid_));
        const int t = t0 + wave * 4 + (lid_ >> 4); const size_t m = (size_t)b * SEQ + t;
        const bf16* zr = Z + m * ZE;
        LAS bf16* Scur = (LAS bf16*)(lds + (sbuf ? R2_SB1 : R2_SB0)); LAS bf16* Snxt = (LAS bf16*)(lds + (sbuf ? R2_SB0 : R2_SB1));
        LAS bf16* Xcur = (LAS bf16*)(lds + (sbuf ? R2_XB1 : R2_XB0)); LAS bf16* Xnxt = (LAS bf16*)(lds + (sbuf ? R2_XB0 : R2_XB1));
        float xr[4], xk[4], xv[4];
        u32x2 vfw, g2;
        v4u cq0 = {0u, 0u, 0u, 0u}, cq1 = {0u, 0u, 0u, 0u};
        if (mode == 1) { const unsigned char* cp = CAu + (size_t)((t0 >> 5) & 31) * 10240; cq0 = *(const v4u*)(cp + 16 * (wave * 64 + lane0)); if (wave < 2) cq1 = *(const v4u*)(cp + 16 * (512 + wave * 64 + lane0)); }
        {
            R2_LANEC();
            const u32x2 r2 = pf_r, k2 = pf_k, v2 = pf_v, w2 = pf_w, a2 = pf_a, pr = pf_pr, pk = pf_pk, pv = pf_pv, pw = pf_pw, pa = pf_pa, e1 = pf_e1, e2 = pf_e2;
            vfw = pf_vf; g2 = pf_g;
            const f32x4 mur = *(const LAS f32x4*)(PAR + 0 * 64 + c4), muk = *(const LAS f32x4*)(PAR + 1 * 64 + c4), muv = *(const LAS f32x4*)(PAR + 2 * 64 + c4), muw = *(const LAS f32x4*)(PAR + 3 * 64 + c4), mua = *(const LAS f32x4*)(PAR + 4 * 64 + c4);
#define R2_UP(w) ((f32x2){bflo(w), bfhi(w)})
            float tw[4], ta[4];
            {
                const unsigned cu[2][5] = {{r2.x, k2.x, v2.x, w2.x, a2.x}, {r2.y, k2.y, v2.y, w2.y, a2.y}}, pu[2][5] = {{pr.x, pk.x, pv.x, pw.x, pa.x}, {pr.y, pk.y, pv.y, pw.y, pa.y}};
#pragma unroll
                for (int h2 = 0; h2 < 2; ++h2) {
                    const f32x2 m_r = {mur[2 * h2], mur[2 * h2 + 1]}, m_k = {muk[2 * h2], muk[2 * h2 + 1]}, m_v = {muv[2 * h2], muv[2 * h2 + 1]}, m_w = {muw[2 * h2], muw[2 * h2 + 1]}, m_a = {mua[2 * h2], mua[2 * h2 + 1]};
                    const f32x2 c_r = R2_UP(cu[h2][0]), c_k = R2_UP(cu[h2][1]), c_v = R2_UP(cu[h2][2]), c_w = R2_UP(cu[h2][3]), c_a = R2_UP(cu[h2][4]);
                    const f32x2 x_r = c_r + (R2_UP(pu[h2][0]) - c_r) * m_r, x_k = c_k + (R2_UP(pu[h2][1]) - c_k) * m_k, x_v = c_v + (R2_UP(pu[h2][2]) - c_v) * m_v;
                    const f32x2 x_w = c_w + (R2_UP(pu[h2][3]) - c_w) * m_w, x_a = c_a + (R2_UP(pu[h2][4]) - c_a) * m_a;
                    xr[2 * h2] = x_r.x; xr[2 * h2 + 1] = x_r.y; xk[2 * h2] = x_k.x; xk[2 * h2 + 1] = x_k.y; xv[2 * h2] = x_v.x; xv[2 * h2 + 1] = x_v.y;
                    const f32x2 t2 = x_w * (f32x2){2.8853900817779268f, 2.8853900817779268f}; f32x2 ex = {__builtin_amdgcn_exp2f(t2.x), __builtin_amdgcn_exp2f(t2.y)}; ex = ex + (f32x2){1.f, 1.f};
                    const f32x2 rc = {__builtin_amdgcn_rcpf(ex.x), __builtin_amdgcn_rcpf(ex.y)}; const f32x2 th = (f32x2){1.f, 1.f} - rc * (f32x2){2.f, 2.f};
                    tw[2 * h2] = th.x; tw[2 * h2 + 1] = th.y; ta[2 * h2] = x_a.x; ta[2 * h2 + 1] = x_a.y;
                }
            }
#undef R2_UP
            *(LAS u32x2*)(TXW + tk * R2_S72 + c4) = (u32x2){pkbf(tw[0], tw[1]), pkbf(tw[2], tw[3])};
            *(LAS u32x2*)(XAS + tk * R2_S72 + c4) = (u32x2){pkbf(ta[0], ta[1]), pkbf(ta[2], ta[3])};
            if (e > 0 && cg < 8) {
                *(LAS u32x2*)(EES + tk * R2_S40 + c4) = (u32x2){pkbf(bflo(e1.x) + bflo(e2.x), bfhi(e1.x) + bfhi(e2.x)), pkbf(bflo(e1.y) + bflo(e2.y), bfhi(e1.y) + bfhi(e2.y))};
            }
            if (t0 + 32 < tend) {
                const bf16* zn = zr + (size_t)32 * ZE; const bf16* zq = zn - ZE;
                pf_r = *(const u32x2*)(zn + h * 256 + c4); pf_k = *(const u32x2*)(zn + h * 256 + 64 + c4); pf_v = *(const u32x2*)(zn + h * 256 + 128 + c4); pf_g = *(const u32x2*)(zn + h * 256 + 192 + c4);
                pf_w = *(const u32x2*)(zn + ZC_XW + c4); pf_a = *(const u32x2*)(zn + ZC_XA + c4);
                pf_pr = *(const u32x2*)(zq + h * 256 + c4); pf_pk = *(const u32x2*)(zq + h * 256 + 64 + c4); pf_pv = *(const u32x2*)(zq + h * 256 + 128 + c4); pf_pw = *(const u32x2*)(zq + ZC_XW + c4); pf_pa = *(const u32x2*)(zq + ZC_XA + c4);
                if (e > 0) { pf_vf = *(const u32x2*)(VF + (m + 32) * 1024 + hc + c4); if (cg < 8) { pf_e1 = *(const u32x2*)(zn + ZC_E1 + c4); pf_e2 = *(const u32x2*)(zq + ZC_E2 + c4); } }
            }
        }
        R2_BAR();
        if (wave < 4) {
            R2_LANEC();
            const int ct = wave;
            f32x4 aw[2];
            {
                const bf16x8 wf0 = ldfrag(W2T + 16 * ct * R2_S72, R2_S72, lane), wf1 = ldfrag(W2T + 16 * ct * R2_S72 + 32, R2_S72, lane);
                const bf16x8 x00 = ldfrag(TXW, R2_S72, lane), x01 = ldfrag(TXW + 32, R2_S72, lane), x10 = ldfrag(TXW + 16 * R2_S72, R2_S72, lane), x11 = ldfrag(TXW + 16 * R2_S72 + 32, R2_S72, lane);
                const f32x4 z4 = {0.f, 0.f, 0.f, 0.f};
                aw[0] = MFMA16(wf0, x00, z4); aw[1] = MFMA16(wf0, x10, z4); aw[0] = MFMA16(wf1, x01, aw[0]); aw[1] = MFMA16(wf1, x11, aw[1]);
            }
            f32x4 pc[2];
#pragma unroll
            for (int tt = 0; tt < 2; ++tt)
#pragma unroll
                for (int h2 = 0; h2 < 2; ++h2) {
                    const f32x2 x2 = (f32x2){w0v[2 * h2], w0v[2 * h2 + 1]} + (f32x2){aw[tt][2 * h2], aw[tt][2 * h2 + 1]};
                    const f32x2 t2 = x2 * (f32x2){-1.4426950408889634f, -1.4426950408889634f};
                    const f32x2 e2 = (f32x2){__builtin_amdgcn_exp2f(t2.x), __builtin_amdgcn_exp2f(t2.y)} + (f32x2){1.f, 1.f};
                    const f32x2 l2 = (f32x2){__builtin_amdgcn_rcpf(e2.x), __builtin_amdgcn_rcpf(e2.y)} * (f32x2){-0.8750387749597071f, -0.8750387749597071f};
                    pc[tt][2 * h2] = l2.x; pc[tt][2 * h2 + 1] = l2.y;
                }
#define R2_SCAN(SH) _Pragma("unroll") for (int tt = 0; tt < 2; ++tt) _Pragma("unroll") for (int r = 0; r < 4; ++r) { float y_; asm volatile("v_add_f32_dpp %0, %1, %1 row_shr:" #SH " row_mask:0xf bank_mask:0xf bound_ctrl:1" : "=v"(y_) : "v"(pc[tt][r])); pc[tt][r] = y_; }
            asm volatile("s_nop 1" ::: "memory");
            R2_SCAN(1) R2_SCAN(2) R2_SCAN(4) R2_SCAN(8)
#undef R2_SCAN
            asm volatile("s_nop 1" ::: "memory");
#pragma unroll
            for (int r = 0; r < 4; ++r) { float y_; asm volatile("v_add_f32_dpp %0, %1, %2 row_newbcast:15 row_mask:0xf bank_mask:0xf" : "=v"(y_) : "v"(pc[0][r]), "v"(pc[1][r])); pc[1][r] = y_; }
#pragma unroll
            for (int tt = 0; tt < 2; ++tt) *(LAS f32x4*)(LCUM + (16 * tt + n) * R2_F68 + 16 * ct + 4 * q) = pc[tt];
        } else {
            R2_LANEC();
            const int ct = wave - 4;
            {
                const bf16x8 af0 = ldfrag(A2T + 16 * ct * R2_S72, R2_S72, lane), af1 = ldfrag(A2T + 16 * ct * R2_S72 + 32, R2_S72, lane);
                const bf16x8 x00 = ldfrag(XAS, R2_S72, lane), x01 = ldfrag(XAS + 32, R2_S72, lane), x10 = ldfrag(XAS + 16 * R2_S72, R2_S72, lane), x11 = ldfrag(XAS + 16 * R2_S72 + 32, R2_S72, lane);
                const f32x4 z4 = {0.f, 0.f, 0.f, 0.f};
                f32x4 aa0, aa1, av0 = z4, av1 = z4;
                if (e > 0) { const bf16x8 vf = ldfrag(V2T + 16 * ct * R2_S40, R2_S40, lane), e0 = ldfrag(EES, R2_S40, lane), e1 = ldfrag(EES + 16 * R2_S40, R2_S40, lane);
                    av0 = MFMA16(vf, e0, z4); av1 = MFMA16(vf, e1, z4); }
                aa0 = MFMA16(af0, x00, z4); aa1 = MFMA16(af0, x10, z4); aa0 = MFMA16(af1, x01, aa0); aa1 = MFMA16(af1, x11, aa1);
                *(LAS f32x4*)(LAF + n * R2_F68 + 16 * ct + 4 * q) = aa0; *(LAS f32x4*)(LAF + (16 + n) * R2_F68 + 16 * ct + 4 * q) = aa1;
                *(LAS f32x4*)(LVF + n * R2_F68 + 16 * ct + 4 * q) = av0; *(LAS f32x4*)(LVF + (16 + n) * R2_F68 + 16 * ct + 4 * q) = av1;
            }
        }
        R2_BAR();
        float vv[4];
        {
            R2_LANEC();
            const f32x4 la = *(const LAS f32x4*)(LAF + tk * R2_F68 + c4), lv = *(const LAS f32x4*)(LVF + tk * R2_F68 + c4);
            const f32x4 Lc = *(const LAS f32x4*)(LCUM + tk * R2_F68 + c4), Le = *(const LAS f32x4*)(LCUM + 31 * R2_F68 + c4);
            f32x4 Lp = {0.f, 0.f, 0.f, 0.f}; if (tk > 0) Lp = *(const LAS f32x4*)(LCUM + (tk - 1) * R2_F68 + c4);
            const float vf[4] = {bflo(vfw.x), bfhi(vfw.x), bflo(vfw.y), bfhi(vfw.y)};
            const f32x4 a0c = *(const LAS f32x4*)(PAR + 5 * 64 + c4), kkc = *(const LAS f32x4*)(PAR + 6 * 64 + c4), kac = *(const LAS f32x4*)(PAR + 7 * 64 + c4), rkc = *(const LAS f32x4*)(PAR + 8 * 64 + c4), v0c = *(const LAS f32x4*)(PAR + 11 * 64 + c4);
            const f32x2 NL2E = {-1.4426950408889634f, -1.4426950408889634f}, ONE = {1.f, 1.f};
            f32x2 kkr[2], kn[2], alr[2], vv2[2], xr2[2], ss2 = {0.f, 0.f}, bon2 = {0.f, 0.f};
#pragma unroll
            for (int h2 = 0; h2 < 2; ++h2) {
                const f32x2 xk2 = {xk[2 * h2], xk[2 * h2 + 1]}, xv2 = {xv[2 * h2], xv[2 * h2 + 1]}; xr2[h2] = (f32x2){xr[2 * h2], xr[2 * h2 + 1]};
                const f32x2 a0_ = {a0c[2 * h2], a0c[2 * h2 + 1]}, la_ = {la[2 * h2], la[2 * h2 + 1]}, kkc_ = {kkc[2 * h2], kkc[2 * h2 + 1]}, kac_ = {kac[2 * h2], kac[2 * h2 + 1]}, rkc_ = {rkc[2 * h2], rkc[2 * h2 + 1]};
                const f32x2 ta = (a0_ + la_) * NL2E; f32x2 ea = {__builtin_amdgcn_exp2f(ta.x), __builtin_amdgcn_exp2f(ta.y)}; ea = ea + ONE;
                alr[h2] = (f32x2){__builtin_amdgcn_rcpf(ea.x), __builtin_amdgcn_rcpf(ea.y)};
                if (e > 0) {
                    const f32x2 v0_ = {v0c[2 * h2], v0c[2 * h2 + 1]}, lv_ = {lv[2 * h2], lv[2 * h2 + 1]}, vf_ = {vf[2 * h2], vf[2 * h2 + 1]};
                    const f32x2 tv = (v0_ + lv_) * NL2E; f32x2 ev = {__builtin_amdgcn_exp2f(tv.x), __builtin_amdgcn_exp2f(tv.y)}; ev = ev + ONE;
                    const f32x2 sg = {__builtin_amdgcn_rcpf(ev.x), __builtin_amdgcn_rcpf(ev.y)};
                    vv2[h2] = xv2 + (vf_ - xv2) * sg;
                } else vv2[h2] = xv2;
                kkr[h2] = xk2 * kkc_; ss2 = ss2 + kkr[h2] * kkr[h2];
                kn[h2] = xk2 * (ONE + (alr[h2] - ONE) * kac_);
                bon2 = bon2 + xr2[h2] * kn[h2] * rkc_;
                vv[2 * h2] = vv2[h2].x; vv[2 * h2 + 1] = vv2[h2].y;
            }
            if (e == 0 && mode == 1) { u32x2 o; o.x = pkbf(xv[0], xv[1]); o.y = pkbf(xv[2], xv[3]); *(u32x2*)(VF + m * 1024 + hc + c4) = o; }
            const float ss = red16(ss2.x + ss2.y), bon = red16(bon2.x + bon2.y);
            const float inv = __builtin_amdgcn_rsqf(ss + 1e-12f);
            unsigned wah[2], wbh[2], wkh[2], wrh[2], wbgh[2], wkgh[2], wvvh[2];
#pragma unroll
            for (int h2 = 0; h2 < 2; ++h2) {
                const f32x2 Lc_ = {Lc[2 * h2], Lc[2 * h2 + 1]}, Lp_ = {Lp[2 * h2], Lp[2 * h2 + 1]}, Le_ = {Le[2 * h2], Le[2 * h2 + 1]};
                const f32x2 k1 = kkr[h2] * inv, bv = k1 * alr[h2];
                const f32x2 tL = Lc_, tP = Lp_, tE = Le_;
                const f32x2 eL = {__builtin_amdgcn_exp2f(tL.x), __builtin_amdgcn_exp2f(tL.y)}, eLp = {__builtin_amdgcn_exp2f(tP.x), __builtin_amdgcn_exp2f(tP.y)};
                f32x2 eN = {0.f, 0.f}, eD;
                if (mode == 0) { const f32x2 eE = {__builtin_amdgcn_exp2f(tE.x), __builtin_amdgcn_exp2f(tE.y)}; eN = (f32x2){__builtin_amdgcn_rcpf(eL.x), __builtin_amdgcn_rcpf(eL.y)}; eD = eE * eN; }
                else { const f32x2 tD = tE - tL; eD = (f32x2){__builtin_amdgcn_exp2f(tD.x), __builtin_amdgcn_exp2f(tD.y)}; }
                const f32x2 ah = -(k1 * eLp), rh = xr2[h2] * eL, bg = bv * eD, kg = kn[h2] * eD;
                wah[h2] = pkbf(ah.x, ah.y); wrh[h2] = pkbf(rh.x, rh.y);
                if (mode == 0) { const f32x2 bh = bv * eN, kh = kn[h2] * eN; wbh[h2] = pkbf(bh.x, bh.y); wkh[h2] = pkbf(kh.x, kh.y); }
                const unsigned wbg = pkbf(bg.x, bg.y), wkg = pkbf(kg.x, kg.y), wvv = pkbf(vv2[h2].x, vv2[h2].y);
                wbgh[h2] = wbg; wkgh[h2] = wkg; wvvh[h2] = wvv;
                if (tk == 31) { GC[c4 + 2 * h2] = eL.x; GC[c4 + 2 * h2 + 1] = eL.y; }
            }
            *(LAS u32x2*)(AH + tk * R2_S72 + c4) = (u32x2){wah[0], wah[1]};
            *(LAS u32x2*)(BGT + tk * R2_S72 + c4) = (u32x2){wbgh[0], wbgh[1]}; *(LAS u32x2*)(KGT + tk * R2_S72 + c4) = (u32x2){wkgh[0], wkgh[1]}; *(LAS u32x2*)(VT + tk * R2_S72 + c4) = (u32x2){wvvh[0], wvvh[1]};
            *(LAS u32x2*)(RH + tk * R2_S72 + c4) = (u32x2){wrh[0], wrh[1]};
            if (mode == 0) { *(LAS u32x2*)(BH + tk * R2_S72 + c4) = (u32x2){wbh[0], wbh[1]}; *(LAS u32x2*)(KH + tk * R2_S72 + c4) = (u32x2){wkh[0], wkh[1]}; }
            if (cg == 0) BON[tk] = bon;
            if (mode == 1) { const int p = wave * 64 + lane; if (p < 480) *(LAS v4u*)(lds + R2_LAK + 16 * p) = cq0; else *(LAS v4u*)(TMC + 16 * (p - 480)) = cq0; if (wave < 2) *(LAS v4u*)(TMC + 16 * (32 + p)) = cq1; }
        }
        R2_BAR();
        if (mode == 0) {
            R2_LANEC(); R2_FOFF();
            const int p = wave >> 1, half = wave & 1;
            const LAS bf16* As = (p & 1) ? KH : BH; const LAS bf16* Bs = (p < 2) ? AH : RH;
#pragma unroll
            for (int ti = 0; ti < 2; ++ti) {
                if (half == 1 && ti == 1) break;
                const int mt = (half == 1) ? 0 : ti, nt = (half == 1) ? 1 : ti;
                f32x4 acc = {0.f, 0.f, 0.f, 0.f};
                { const bf16x8 a0 = ldfo(As + 16 * mt * R2_S72, F72), a1 = ldfo(As + 16 * mt * R2_S72 + 32, F72), b0 = ldfo(Bs + 16 * nt * R2_S72, F72), b1 = ldfo(Bs + 16 * nt * R2_S72 + 32, F72);
                  acc = MFMA16(a0, b0, acc); acc = MFMA16(a1, b1, acc); }
                const int nn = 16 * nt + n, m0 = 16 * mt + 4 * q;
#pragma unroll
                for (int r = 0; r < 4; ++r) { const bool keep = (p < 2) ? (m0 + r < nn) : (m0 + r <= nn); acc[r] = keep ? acc[r] : 0.f; }
                if (p == 0) *(LAS f32x4*)(LAB + nn * 32 + m0) = acc;
                else st_no(((p == 1) ? LAK : (p == 2) ? QRB : QRK) + 16 * nt * R2_S40 + 16 * mt, N40, acc);
            }
            if (half == 1 && p > 0) {
                LAS bf16* O = (p == 1) ? LAK : (p == 2) ? QRB : QRK;
                *(LAS u32x2*)(O + n * R2_S40 + 16 + 4 * q) = (u32x2){0u, 0u};
            }
        }
        if (mode == 0) R2_BAR();
        if (mode == 1) {
            R2_LANEC(); R2_FOFF();
            const int vt = wave >> 1, hf = wave & 1;
#define R2_PK2(x0, x1) __builtin_bit_cast(bf16x8, (v4u){pkbf((x0)[0], (x0)[1]), pkbf((x0)[2], (x0)[3]), pkbf((x1)[0], (x1)[1]), pkbf((x1)[2], (x1)[3])})
#define R2_LDP(dst, p) { const u32x2 lo_ = *(const LAS u32x2*)((p) + 4 * q), hi_ = *(const LAS u32x2*)((p) + 16 + 4 * q); dst = __builtin_bit_cast(bf16x8, (v4u){lo_.x, lo_.y, hi_.x, hi_.y}); }
            const bf16x8 sb0 = ldfo(Scur + 16 * vt * R2_S72, F72), sb1 = ldfo(Scur + 16 * vt * R2_S72 + 32, F72), vb = r2_trf(VT, 8 * q, 8 * q + 4, 16 * vt, n);
            const bf16x8 a00 = ldfo(AH, F72), a01 = ldfo(AH + 32, F72), a10 = ldfo(AH + 16 * R2_S72, F72), a11 = ldfo(AH + 16 * R2_S72 + 32, F72), l0 = ldfo(LAK, F40), l1 = ldfo(LAK + 16 * R2_S40, F40);
            bf16x8 t0, t1, qb;
            R2_LDP(t0, (const LAS bf16*)TMC + n * R2_S40); R2_LDP(t1, (const LAS bf16*)TMC + (16 + n) * R2_S40);
            R2_LDP(qb, QRB + (16 * hf + n) * R2_S40);
            const bf16x8 bg0 = r2_trf(BGT, 4 * q, 16 + 4 * q, 32 * hf, n), bg1 = r2_trf(BGT, 4 * q, 16 + 4 * q, 32 * hf + 16, n);
            const bf16x8 rh0 = ldfo(RH + 16 * hf * R2_S72, F72), rh1 = ldfo(RH + 16 * hf * R2_S72 + 32, F72), qk = ldfo(QRK + 16 * hf * R2_S40, F40);
            const bf16x8 kg0 = r2_trf(KGT, 8 * q, 8 * q + 4, 32 * hf, n), kg1 = r2_trf(KGT, 8 * q, 8 * q + 4, 32 * hf + 16, n);
            const f32x4 g40 = *(const LAS f32x4*)(GC + 32 * hf + 4 * q), g41 = *(const LAS f32x4*)(GC + 32 * hf + 16 + 4 * q);
            const f32x4 z4 = {0.f, 0.f, 0.f, 0.f};
            f32x4 r0 = z4, r1 = z4;
            r0 = MFMA16(a00, sb0, r0); r1 = MFMA16(a10, sb0, r1); r0 = MFMA16(a01, sb1, r0); r1 = MFMA16(a11, sb1, r1); r0 = MFMA16(l0, vb, r0); r1 = MFMA16(l1, vb, r1);
            f32x4 ay = z4; ay = MFMA16(sb0, rh0, ay); ay = MFMA16(sb1, rh1, ay); ay = MFMA16(vb, qk, ay);
            f32x4 s0 = accS[0] * g40, s1 = accS[1] * g41;
            s0 = MFMA16(kg0, vb, s0); s1 = MFMA16(kg1, vb, s1);
            const bf16x8 rb = R2_PK2(r0, r1);
            f32x4 u0 = z4, u1 = z4; u0 = MFMA16(t0, rb, u0); u1 = MFMA16(t1, rb, u1);
            const bf16x8 ub = R2_PK2(u0, u1);
            ay = MFMA16(ub, qb, ay); s0 = MFMA16(bg0, ub, s0); s1 = MFMA16(bg1, ub, s1);
            *(LAS f32x4*)(YS + (16 * hf + n) * R2_F68 + 16 * vt + 4 * q) = ay;
            accS[0] = s0; accS[1] = s1;
            st_no(Snxt + 16 * vt * R2_S72 + 32 * hf, N72, s0); st_no(Snxt + 16 * vt * R2_S72 + 32 * hf + 16, N72, s1);
#undef R2_PK2
#undef R2_LDP
            R2_BAR();
        } else {
        if (wave == 0 && mode == 0) {
            R2_LANEC();
            const int blk = (lane >> 4) & 1; float d[16];
            {
                f32x4 le[2][2], lt[2];
                d[0] = (n == 0) ? 1.f : 0.f;
                le[1][0] = *(const LAS f32x4*)(LAB + (16 * blk + 1) * 32 + 16 * blk);
#pragma unroll
                for (int i = 1; i < 16; ++i) {
                    if (i > 8) lt[0] = *(const LAS f32x4*)(LAB + (16 * blk + i) * 32 + 16 * blk + 8);
                    if (i > 12) lt[1] = *(const LAS f32x4*)(LAB + (16 * blk + i) * 32 + 16 * blk + 12);
                    if (i + 1 < 16) { le[(i + 1) & 1][0] = *(const LAS f32x4*)(LAB + (16 * blk + i + 1) * 32 + 16 * blk); if (i + 1 > 4) le[(i + 1) & 1][1] = *(const LAS f32x4*)(LAB + (16 * blk + i + 1) * 32 + 16 * blk + 4); }
                    float acc = (i == n) ? 1.f : 0.f, acb = 0.f;
#define R2_FMAC(a_, x_, y_) asm("v_fmac_f32 %0, %1, %2" : "+v"(a_) : "v"(x_), "v"(y_))
#pragma unroll
                    for (int j = 0; j < 8; ++j) if (j < i) { const float l_ = le[i & 1][j >> 2][j & 3]; if (j & 1) R2_FMAC(acb, l_, d[j]); else R2_FMAC(acc, l_, d[j]); }
#pragma unroll
                    for (int j = 8; j < 16; ++j) if (j < i) { const float l_ = lt[(j - 8) >> 2][j & 3]; if (j & 1) R2_FMAC(acb, l_, d[j]); else R2_FMAC(acc, l_, d[j]); }
#undef R2_FMAC
                    d[i] = acc + acb;
                    asm volatile("" ::: "memory");
                }
#pragma unroll
                for (int i = 0; i < 16; i += 2) { const unsigned w = pkbf(d[i], d[i + 1]); const bf16 lo = (bf16)(w & 0xffffu), hi = (bf16)(w >> 16);
                    TM[(16 * blk + i) * R2_S40 + 16 * blk + n] = lo; TM[(16 * blk + i + 1) * R2_S40 + 16 * blk + n] = hi; }
#pragma unroll
                for (int i4 = 0; i4 < 4; ++i4) *(LAS u32x2*)(DTM + (16 * blk + n) * R2_S40 + 4 * i4) = (u32x2){pkbf(d[4 * i4], d[4 * i4 + 1]), pkbf(d[4 * i4 + 2], d[4 * i4 + 3])};
            }
            asm volatile("s_waitcnt lgkmcnt(0)" ::: "memory");
            bf16x8 afr;
            { const int q1 = q & 1; const f32x4 l0 = *(const LAS f32x4*)(LAB + (16 + n) * 32 + 8 * q1), l1 = *(const LAS f32x4*)(LAB + (16 + n) * 32 + 8 * q1 + 4);
                v4u w = {pkbf(l0[0], l0[1]), pkbf(l0[2], l0[3]), pkbf(l1[0], l1[1]), pkbf(l1[2], l1[3])}; if (q >= 2) w = (v4u){0u, 0u, 0u, 0u}; afr = __builtin_bit_cast(bf16x8, w); }
            f32x4 mac = {0.f, 0.f, 0.f, 0.f};
            mac = MFMA16(afr, ldfrag16(DTM, R2_S40, lane), mac);
            st_nat(MT, R2_S40, 0, lane, mac);
            asm volatile("s_waitcnt lgkmcnt(0)" ::: "memory");
            f32x4 tac = {0.f, 0.f, 0.f, 0.f};
            tac = MFMA16(ldfrag16(TM + 16 * R2_S40 + 16, R2_S40, lane), ldfrag16(MT, R2_S40, lane), tac);
            { const unsigned w0 = pkbf(tac[0], tac[1]), w1 = pkbf(tac[2], tac[3]); TM[(16 + 4 * q + 0) * R2_S40 + n] = (bf16)(w0 & 0xffffu); TM[(16 + 4 * q + 1) * R2_S40 + n] = (bf16)(w0 >> 16); TM[(16 + 4 * q + 2) * R2_S40 + n] = (bf16)(w1 & 0xffffu); TM[(16 + 4 * q + 3) * R2_S40 + n] = (bf16)(w1 >> 16); }
        } else if (wave == 1 && mode == 0) {
            R2_LANEC();
            *(LAS u32x2*)(TM + (lane >> 2) * R2_S40 + 16 + 4 * (lane & 3)) = (u32x2){0u, 0u};
        } else if (wave >= 4) {
            R2_LANEC(); R2_FOFF();
            const int vt = wave - 4;
            const bf16x8 sb0 = ldfo(Scur + 16 * vt * R2_S72, F72), sb1 = ldfo(Scur + 16 * vt * R2_S72 + 32, F72), vb = r2_trf(VT, 8 * q, 8 * q + 4, 16 * vt, n);
            const bf16x8 a00 = ldfo(AH, F72), a01 = ldfo(AH + 32, F72), a10 = ldfo(AH + 16 * R2_S72, F72), a11 = ldfo(AH + 16 * R2_S72 + 32, F72), l0 = ldfo(LAK, F40), l1 = ldfo(LAK + 16 * R2_S40, F40);
            f32x4 ac0 = {0.f, 0.f, 0.f, 0.f}, ac1 = {0.f, 0.f, 0.f, 0.f};
            ac0 = MFMA16(a00, sb0, ac0); ac1 = MFMA16(a10, sb0, ac1); ac0 = MFMA16(a01, sb1, ac0); ac1 = MFMA16(a11, sb1, ac1); ac0 = MFMA16(l0, vb, ac0); ac1 = MFMA16(l1, vb, ac1);
            st_no(W1T + 16 * vt * R2_S40, N40, ac0); st_no(W1T + 16 * vt * R2_S40 + 16, N40, ac1);
        } else if (mode == 0) {
            R2_LANEC(); R2_FOFF();
            const bf16x8 a00 = ldfo(AH, F72), a01 = ldfo(AH + 32, F72), a10 = ldfo(AH + 16 * R2_S72, F72), a11 = ldfo(AH + 16 * R2_S72 + 32, F72);
#pragma unroll
            for (int xi = 0; xi < 2; ++xi) {
                const int xt = 2 * (wave - 2) + xi;
                const bf16x8 xb0 = ldfo(Xcur + 16 * xt * R2_S72, F72), xb1 = ldfo(Xcur + 16 * xt * R2_S72 + 32, F72);
                f32x4 ac0 = {0.f, 0.f, 0.f, 0.f}, ac1 = {0.f, 0.f, 0.f, 0.f};
                ac0 = MFMA16(a00, xb0, ac0); ac1 = MFMA16(a10, xb0, ac1); ac0 = MFMA16(a01, xb1, ac0); ac1 = MFMA16(a11, xb1, ac1);
                st_no(RHX + 16 * xt * R2_S40, N40, ac0); st_no(RHX + 16 * xt * R2_S40 + 16, N40, ac1);
            }
        }
        R2_BAR();
        const int it8 = wave & 1, vt8 = wave >> 1; (void)it8; (void)vt8;
        {
            R2_LANEC(); R2_FOFF();
#define R2_PK2(x0, x1) __builtin_bit_cast(bf16x8, (v4u){pkbf((x0)[0], (x0)[1]), pkbf((x0)[2], (x0)[3]), pkbf((x1)[0], (x1)[1]), pkbf((x1)[2], (x1)[3])})
            const int ct = wave >> 1, vtb = 2 * (wave & 1);
            const bf16x8 tm0 = ldfo(TM, F40), tm1 = ldfo(TM + 16 * R2_S40, F40);
            const bf16x8 bgp = r2_trf(BGT, 4 * q, 16 + 4 * q, 16 * ct, n), kgf = r2_trf(KGT, 8 * q, 8 * q + 4, 16 * ct, n);
            const f32x4 g4 = *(const LAS f32x4*)(GC + 16 * ct + 4 * q);
            const f32x4 z4 = {0.f, 0.f, 0.f, 0.f};
#pragma unroll
            for (int vi = 0; vi < 2; ++vi) {
                const int vt = vtb + vi;
                const bf16x8 wf = ldfo(W1T + 16 * vt * R2_S40, F40), xf = ldfo(RHX + 16 * vt * R2_S40, F40), vf = r2_trf(VT, 8 * q, 8 * q + 4, 16 * vt, n);
                f32x4 u0 = z4, u1 = z4, x0 = z4, x1 = z4;
                u0 = MFMA16(tm0, wf, u0); u1 = MFMA16(tm1, wf, u1); x0 = MFMA16(tm0, xf, x0); x1 = MFMA16(tm1, xf, x1);
                const bf16x8 ub = R2_PK2(u0, u1), xb = R2_PK2(x0, x1);
                f32x4 a = accS[vi] * g4, ax = accX[vi] * g4;
                a = MFMA16(kgf, vf, a); a = MFMA16(bgp, ub, a); ax = MFMA16(bgp, xb, ax);
                accS[vi] = a; accX[vi] = ax;
                st_no(Snxt + 16 * vt * R2_S72 + 16 * ct, N72, a); st_no(Xnxt + 16 * vt * R2_S72 + 16 * ct, N72, ax);
            }
#undef R2_PK2
                {
                    unsigned char* cp = CAu + (size_t)((t0 >> 5) & 31) * 10240; const int p = wave * 64 + lane;
                    const v4u c0 = (p < 480) ? *(const LAS v4u*)(lds + R2_LAK + 16 * p) : *(const LAS v4u*)(lds + R2_TM + 16 * (p - 480));
                    *(v4u*)(cp + 16 * p) = c0;
                    if (wave < 2) { const v4u c1 = *(const LAS v4u*)(lds + R2_TM + 16 * (32 + p)); *(v4u*)(cp + 16 * (512 + p)) = c1; }
                }
        }
        R2_BAR();
        }
        if (mode == 1) {
            R2_LANEC();
            const f32x4 y4 = *(const LAS f32x4*)(YS + tk * R2_F68 + c4);
            const float mean = red16((y4[0] + y4[1]) + (y4[2] + y4[3])) * (1.0f / 64.0f);
            const f32x2 d0 = (f32x2){y4[0], y4[1]} - mean, d1 = (f32x2){y4[2], y4[3]} - mean;
            const f32x2 dq = d0 * d0 + d1 * d1;
            const float var = red16(dq.x + dq.y) * (1.0f / 64.0f);
            const float rstd = __builtin_amdgcn_rsqf(var + 64e-5f), bo = BON[tk];
            const f32x4 lnw = *(const LAS f32x4*)(PAR + 9 * 64 + c4), lnb = *(const LAS f32x4*)(PAR + 10 * 64 + c4);
            const f32x2 g0 = {bflo(g2.x), bfhi(g2.x)}, g1 = {bflo(g2.y), bfhi(g2.y)};
            const f32x2 n0 = g0 * (f32x2){-1.4426950408889634f, -1.4426950408889634f}, n1 = g1 * (f32x2){-1.4426950408889634f, -1.4426950408889634f};
            const f32x2 e0 = (f32x2){__builtin_amdgcn_exp2f(n0.x), __builtin_amdgcn_exp2f(n0.y)} + (f32x2){1.f, 1.f}, e1 = (f32x2){__builtin_amdgcn_exp2f(n1.x), __builtin_amdgcn_exp2f(n1.y)} + (f32x2){1.f, 1.f};
            const f32x2 s0 = g0 * (f32x2){__builtin_amdgcn_rcpf(e0.x), __builtin_amdgcn_rcpf(e0.y)}, s1 = g1 * (f32x2){__builtin_amdgcn_rcpf(e1.x), __builtin_amdgcn_rcpf(e1.y)};
            const f32x2 o0 = (d0 * rstd * (f32x2){lnw[0], lnw[1]} + (f32x2){lnb[0], lnb[1]} + (f32x2){vv[0], vv[1]} * bo) * s0, o1 = (d1 * rstd * (f32x2){lnw[2], lnw[3]} + (f32x2){lnb[2], lnb[3]} + (f32x2){vv[2], vv[3]} * bo) * s1;
            const float o[4] = {o0.x, o0.y, o1.x, o1.y};
            u32x2 ow; ow.x = pkbf(o[0], o[1]); ow.y = pkbf(o[2], o[3]);
            *(u32x2*)(Y + m * 2048 + hc + c4) = ow;
        }
        sbuf ^= 1;
    }
    if (mode == 0) {
        const int q_ = lane0 >> 4, n_ = lane0 & 15, ct_ = wave >> 1;
#pragma unroll
        for (int vi = 0; vi < 2; ++vi)
#pragma unroll
            for (int r = 0; r < 4; ++r) { const int idx = (16 * ct_ + 4 * q_ + r) * 64 + 16 * (2 * (wave & 1) + vi) + n_; MGu[idx] = accX[vi][r]; MGu[4096 + idx] = accS[vi][r]; }
    }
    __syncthreads();
#undef R2_LANE
#undef R2_BAR
}

constexpr int E12_LD = 1032;
__device__ __forceinline__ void conv_e12_mfma(LAS unsigned char* lds, const float* W  , const float* g  , const float* muv  , const float* v1  , bf16* WT, const int tid, const int wave) {
    if ((int)blockIdx.x >= 128) return;
    LAS bf16* BT = (LAS bf16*)lds;
    __syncthreads();
    {
        f32x4 vq[16]; float mq[16];
#pragma unroll
        for (int i = 0; i < 16; ++i) { const int it = tid + 512 * i, c = it >> 3, j4 = 4 * (it & 7); vq[i] = *(const f32x4*)(v1 + c * 32 + j4); mq[i] = muv[c]; }
#pragma unroll
        for (int i = 0; i < 16; ++i) { const int it = tid + 512 * i, c = it >> 3, j4 = 4 * (it & 7); const float mu = mq[i], om = 1.0f - mu;
#pragma unroll
            for (int e2 = 0; e2 < 4; ++e2) { BT[(j4 + e2) * E12_LD + c] = (bf16)f2bf(om * vq[i][e2]); BT[(32 + j4 + e2) * E12_LD + c] = (bf16)f2bf(mu * vq[i][e2]); } }
    }
    __syncthreads();
#pragma unroll 1
    for (int kt = (int)blockIdx.x; kt < 128; kt += (int)gridDim.x)
    if (wave < 4) {
        int lane = (int)__builtin_amdgcn_mbcnt_hi(~0u, __builtin_amdgcn_mbcnt_lo(~0u, 0u)); asm volatile("" : "+v"(lane));
        const int q = lane >> 4, n = lane & 15, nt = wave, k0 = 16 * kt;
        const float* wrow = W + (size_t)(k0 + n) * ECOLS + 2048 + 8 * q;
        f32x4 acc = {0.f, 0.f, 0.f, 0.f};
#pragma unroll 1
        for (int kb = 0; kb < 32; kb += 8) {
            f32x4 wq[16];
#pragma unroll
            for (int u = 0; u < 8; ++u) { wq[2 * u] = *(const f32x4*)(wrow + 32 * (kb + u)); wq[2 * u + 1] = *(const f32x4*)(wrow + 32 * (kb + u) + 4); }
            asm volatile("s_waitcnt vmcnt(0)" ::: "memory");
#pragma unroll
            for (int u = 0; u < 8; ++u) {
                const f32x4 w0 = wq[2 * u], w1 = wq[2 * u + 1];
                const bf16x8 a = __builtin_bit_cast(bf16x8, (v4u){pkbf(w0[0], w0[1]), pkbf(w0[2], w0[3]), pkbf(w1[0], w1[1]), pkbf(w1[2], w1[3])});
                acc = MFMA16(a, ldfrag(BT + 16 * nt * E12_LD + 32 * (kb + u), E12_LD, lane), acc);
            }
        }
        const f32x4 g4 = *(const f32x4*)(g + k0 + 4 * q);
        *(u32x2*)(WT + (size_t)(ZC_E1 + 16 * nt + n) * 2048 + k0 + 4 * q) = (u32x2){pkbf(acc[0] * g4[0], acc[1] * g4[1]), pkbf(acc[2] * g4[2], acc[3] * g4[3])};
    }
    __syncthreads();
}

struct SguP { const float *lnw, *lnb, *ws, *bs; const unsigned long long *st1, *st2; };

constexpr int AT_KLD = 72, AT_VOFF = 36864, AT_CSOFF = 73728, AT_GOFF = 81920, AT_GLD = 264;
typedef short at_s16x4 __attribute__((ext_vector_type(4)));
__device__ __forceinline__ at_s16x4 at_tr(const LAS bf16* p) { return __builtin_bit_cast(at_s16x4, __builtin_amdgcn_ds_read_tr16_b64_v4i16((LAS at_s16x4*)p)); }
constexpr float AT_QS = 0.125f * 1.4426950408889634f;
__device__ __forceinline__ void attn_v2_unit(LAS unsigned char* lds, int b, int g, int nb, const bf16* Z, bf16* Y, const float* COS, const float* SIN, const float* sinks, const int tid, const int wave) {
    LAS bf16* KS = (LAS bf16*)lds; LAS bf16* VS = (LAS bf16*)(lds + AT_VOFF); LAS float* CS = (LAS float*)(lds + AT_CSOFF); LAS bf16* GT = (LAS bf16*)(lds + AT_GOFF);
    const int hq = 4 * g + (wave >> 1); const float sinkl = sinks[hq] * 1.4426950408889634f;
    const size_t mq0 = (size_t)b * SEQ + nb * 128;
    v4u qraw[2][2];
    { const int l_ = tid & 63; const bf16* qp = Z + (mq0 + 64 * (wave & 1) + (l_ & 15)) * ZE + ZC_Q + hq * 64 + 8 * (l_ >> 4);
#pragma unroll
      for (int qt = 0; qt < 2; ++qt) { qraw[qt][0] = *(const v4u*)(qp + (size_t)16 * qt * ZE); qraw[qt][1] = *(const v4u*)(qp + (size_t)16 * qt * ZE + 32); } }
    __syncthreads();
    {
        int lane = tid & 63; asm volatile("" : "+v"(lane)); const int tt_ = wave * 64 + lane;
        const int pc = tt_ & 7, r0 = tt_ >> 3;
        v4u gq[8], kq[4], vq[4]; f32x4 cs[4][4];
#pragma unroll
        for (int i = 0; i < 8; ++i) { const int p = tt_ + 512 * i; gq[i] = *(const v4u*)(Z + (mq0 + (p >> 5)) * ZE + ZC_BG + 256 * g + 8 * (p & 31)); }
#pragma unroll
        for (int i = 0; i < 4; ++i) {
            const int fr = r0 + 64 * i, tt = (nb - 1) * 128 + fr; const bool valid = tt >= 0; const size_t mk = (size_t)b * SEQ + (valid ? tt : 0);
            kq[i] = *(const v4u*)(Z + mk * ZE + ZC_KB + g * 64 + 8 * pc); vq[i] = *(const v4u*)(Z + mk * ZE + ZC_VB + g * 64 + 8 * pc);
            if (pc < 2) { cs[i][0] = *(const f32x4*)(COS + mk * 8); cs[i][1] = *(const f32x4*)(COS + mk * 8 + 4); cs[i][2] = *(const f32x4*)(SIN + mk * 8); cs[i][3] = *(const f32x4*)(SIN + mk * 8 + 4); }
        }
#pragma unroll
        for (int i = 0; i < 8; ++i) { const int p = tt_ + 512 * i; *(LAS v4u*)(GT + (p >> 5) * AT_GLD + 8 * (p & 31)) = gq[i]; }
#pragma unroll
        for (int i = 0; i < 4; ++i) {
            const int fr = r0 + 64 * i; const bool valid = (nb - 1) * 128 + fr >= 0;
            v4u kw = kq[i];
            const unsigned q0_ = (unsigned)__builtin_amdgcn_update_dpp(0, (int)kw.x, 0xB1, 0xF, 0xF, true), q1_ = (unsigned)__builtin_amdgcn_update_dpp(0, (int)kw.y, 0xB1, 0xF, 0xF, true),
                           q2_ = (unsigned)__builtin_amdgcn_update_dpp(0, (int)kw.z, 0xB1, 0xF, 0xF, true), q3_ = (unsigned)__builtin_amdgcn_update_dpp(0, (int)kw.w, 0xB1, 0xF, 0xF, true);
            if (pc < 2) {
                if (pc == 0 && fr >= 128) { LAS float* cp = CS + (fr - 128) * 16; *(LAS f32x4*)cp = cs[i][0]; *(LAS f32x4*)(cp + 4) = cs[i][1]; *(LAS f32x4*)(cp + 8) = cs[i][2]; *(LAS f32x4*)(cp + 12) = cs[i][3]; }
                const float sg = (pc == 0) ? -1.0f : 1.0f;
                const float xm[8] = {bflo(kw.x), bfhi(kw.x), bflo(kw.y), bfhi(kw.y), bflo(kw.z), bfhi(kw.z), bflo(kw.w), bfhi(kw.w)};
                const float xp[8] = {bflo(q0_), bfhi(q0_), bflo(q1_), bfhi(q1_), bflo(q2_), bfhi(q2_), bflo(q3_), bfhi(q3_)};
                const float cc[8] = {cs[i][0][0], cs[i][0][1], cs[i][0][2], cs[i][0][3], cs[i][1][0], cs[i][1][1], cs[i][1][2], cs[i][1][3]}, sn[8] = {cs[i][2][0], cs[i][2][1], cs[i][2][2], cs[i][2][3], cs[i][3][0], cs[i][3][1], cs[i][3][2], cs[i][3][3]};
                float y[8];
#pragma unroll
                for (int j = 0; j < 8; ++j) y[j] = xm[j] * cc[j] + sg * (xp[j] * sn[j]);
                kw = (v4u){pkbf(y[0], y[1]), pkbf(y[2], y[3]), pkbf(y[4], y[5]), pkbf(y[6], y[7])};
            }
            const v4u zz = {0u, 0u, 0u, 0u};
            *(LAS v4u*)(KS + fr * AT_KLD + 8 * pc) = valid ? kw : zz;
            *(LAS v4u*)(VS + fr * AT_KLD + 8 * pc) = valid ? vq[i] : zz;
        }
    }
    __syncthreads();
    for (int blk = 0; blk < 2; ++blk) {
        int lane = tid & 63; asm volatile("" : "+v"(lane));
        const int qd = lane >> 4, n = lane & 15;
        const int q0 = 64 * (wave & 1) + 32 * blk, kt0 = q0 >> 5;
        const size_t m0 = (size_t)b * SEQ + nb * 128 + q0;
        bf16x8 qf[2][2];
#pragma unroll
        for (int qt = 0; qt < 2; ++qt) {
            const v4u w0 = qraw[qt][0], w1 = qraw[qt][1];
            float x[8] = {bflo(w0.x), bfhi(w0.x), bflo(w0.y), bfhi(w0.y), bflo(w0.z), bfhi(w0.z), bflo(w0.w), bfhi(w0.w)};
            unsigned p0, p1, p2, p3;
            { const auto s0_ = __builtin_amdgcn_permlane16_swap(w0.x, w0.x, false, false), s1_ = __builtin_amdgcn_permlane16_swap(w0.y, w0.y, false, false), s2_ = __builtin_amdgcn_permlane16_swap(w0.z, w0.z, false, false), s3_ = __builtin_amdgcn_permlane16_swap(w0.w, w0.w, false, false);
              const bool odd = (qd & 1) != 0; p0 = odd ? (unsigned)s0_[0] : (unsigned)s0_[1]; p1 = odd ? (unsigned)s1_[0] : (unsigned)s1_[1]; p2 = odd ? (unsigned)s2_[0] : (unsigned)s2_[1]; p3 = odd ? (unsigned)s3_[0] : (unsigned)s3_[1]; }
            const float y[8] = {bflo(p0), bfhi(p0), bflo(p1), bfhi(p1), bflo(p2), bfhi(p2), bflo(p3), bfhi(p3)};
            const LAS float* cp = CS + (q0 + 16 * qt + n) * 16;
            const f32x4 c0 = *(const LAS f32x4*)cp, c1 = *(const LAS f32x4*)(cp + 4), s0 = *(const LAS f32x4*)(cp + 8), s1 = *(const LAS f32x4*)(cp + 12);
            const float cs[8] = {c0[0], c0[1], c0[2], c0[3], c1[0], c1[1], c1[2], c1[3]}, sn[8] = {s0[0], s0[1], s0[2], s0[3], s1[0], s1[1], s1[2], s1[3]};
#pragma unroll
            for (int i = 0; i < 8; ++i) { const float r0 = x[i] * cs[i] - y[i] * sn[i], r1 = x[i] * cs[i] + y[i] * sn[i]; x[i] = (qd == 0) ? r0 : (qd == 1) ? r1 : x[i]; }
            const v4u a = {pkbf(x[0] * AT_QS, x[1] * AT_QS), pkbf(x[2] * AT_QS, x[3] * AT_QS), pkbf(x[4] * AT_QS, x[5] * AT_QS), pkbf(x[6] * AT_QS, x[7] * AT_QS)};
            const v4u bq = {pkbf(bflo(w1.x) * AT_QS, bfhi(w1.x) * AT_QS), pkbf(bflo(w1.y) * AT_QS, bfhi(w1.y) * AT_QS), pkbf(bflo(w1.z) * AT_QS, bfhi(w1.z) * AT_QS), pkbf(bflo(w1.w) * AT_QS, bfhi(w1.w) * AT_QS)};
            qf[qt][0] = __builtin_bit_cast(bf16x8, a); qf[qt][1] = __builtin_bit_cast(bf16x8, bq);
        }
        if (blk == 0) { const bf16* qp = Z + (m0 + 32 + n) * ZE + ZC_Q + hq * 64 + 8 * qd;
#pragma unroll
            for (int qt = 0; qt < 2; ++qt) { qraw[qt][0] = *(const v4u*)(qp + (size_t)16 * qt * ZE); qraw[qt][1] = *(const v4u*)(qp + (size_t)16 * qt * ZE + 32); } }
        f32x4 s[10][2];
        bf16x8 ka0 = ldfrag(KS + (32 * kt0) * AT_KLD, AT_KLD, lane), ka1 = ldfrag(KS + (32 * kt0) * AT_KLD + 32, AT_KLD, lane);
#pragma unroll
        for (int kt = 0; kt < 10; ++kt) {
            const bf16x8 a0 = ka0, a1 = ka1;
            if (kt < 9) { ka0 = ldfrag(KS + (32 * kt0 + 16 * (kt + 1)) * AT_KLD, AT_KLD, lane); ka1 = ldfrag(KS + (32 * kt0 + 16 * (kt + 1)) * AT_KLD + 32, AT_KLD, lane); }
#pragma unroll
            for (int qt = 0; qt < 2; ++qt) { f32x4 acc = {0.f, 0.f, 0.f, 0.f}; if (kt - qt >= 0 && kt - qt <= 8) { acc = MFMA16(a0, qf[qt][0], acc); acc = MFMA16(a1, qf[qt][1], acc); } s[kt][qt] = acc; }
        }
        float inv[2];
#pragma unroll
        for (int qt = 0; qt < 2; ++qt) {
            float mx = sinkl;
#pragma unroll
            for (int kt = 0; kt < 10; ++kt) {
                const int d = kt - qt; if (d < 0 || d > 8) continue;
                const bool tok = (nb > 0) || (kt >= 8 - 2 * kt0);
                if (d != 0 && d != 8) {
                    if (!tok) s[kt][qt] = (f32x4){-INFINITY, -INFINITY, -INFINITY, -INFINITY};
#pragma unroll
                    for (int r = 0; r < 4; ++r) mx = fmaxf(mx, s[kt][qt][r]);
                } else {
#pragma unroll
                    for (int r = 0; r < 4; ++r) { const bool valid = tok && (d != 0 || 4 * qd + r > n) && (d != 8 || 4 * qd + r <= n); const float v = valid ? s[kt][qt][r] : -INFINITY; s[kt][qt][r] = v; mx = fmaxf(mx, v); }
                }
            }
            { const unsigned um = __builtin_bit_cast(unsigned, mx); const auto a_ = __builtin_amdgcn_permlane16_swap(um, um, false, false);
              mx = fmaxf(__builtin_bit_cast(float, (unsigned)a_[0]), __builtin_bit_cast(float, (unsigned)a_[1]));
              const unsigned un = __builtin_bit_cast(unsigned, mx); const auto b_ = __builtin_amdgcn_permlane32_swap(un, un, false, false);
              mx = fmaxf(__builtin_bit_cast(float, (unsigned)b_[0]), __builtin_bit_cast(float, (unsigned)b_[1])); }
            typedef float at_f32x2 __attribute__((ext_vector_type(2)));
            at_f32x2 l2 = {0.f, 0.f}; const at_f32x2 mx2 = {mx, mx};
#pragma unroll
            for (int kt = 0; kt < 10; ++kt) {
                const int d = kt - qt; if (d < 0 || d > 8) { s[kt][qt] = (f32x4){0.f, 0.f, 0.f, 0.f}; continue; }
                const at_f32x2 t0 = (at_f32x2){s[kt][qt][0], s[kt][qt][1]} - mx2, t1 = (at_f32x2){s[kt][qt][2], s[kt][qt][3]} - mx2;
                const at_f32x2 p0 = {__builtin_amdgcn_exp2f(t0.x), __builtin_amdgcn_exp2f(t0.y)}, p1 = {__builtin_amdgcn_exp2f(t1.x), __builtin_amdgcn_exp2f(t1.y)};
                s[kt][qt] = (f32x4){p0.x, p0.y, p1.x, p1.y}; l2 = l2 + p0; l2 = l2 + p1;
            }
            const float l = pg8::rowsum4(l2.x + l2.y);
            inv[qt] = 1.0f / (l + __builtin_amdgcn_exp2f(sinkl - mx));
        }
        f32x4 o[4][2];
#pragma unroll
        for (int dt = 0; dt < 4; ++dt) { o[dt][0] = (f32x4){0.f, 0.f, 0.f, 0.f}; o[dt][1] = o[dt][0]; }
#pragma unroll
        for (int s5 = 0; s5 < 5; ++s5) {
            bf16x8 pf[2];
#pragma unroll
            for (int qt = 0; qt < 2; ++qt) { const v4u w = {pkbf(s[2 * s5][qt][0], s[2 * s5][qt][1]), pkbf(s[2 * s5][qt][2], s[2 * s5][qt][3]), pkbf(s[2 * s5 + 1][qt][0], s[2 * s5 + 1][qt][1]), pkbf(s[2 * s5 + 1][qt][2], s[2 * s5 + 1][qt][3])}; pf[qt] = __builtin_bit_cast(bf16x8, w); }
            at_s16x4 vt0[4], vt1[4];
#pragma unroll
            for (int dt = 0; dt < 4; ++dt) {
                const LAS bf16* vp = VS + (32 * (kt0 + s5) + 4 * qd + (n >> 2)) * AT_KLD + 16 * dt + 4 * (n & 3);
                vt0[dt] = at_tr(vp); vt1[dt] = at_tr(vp + 16 * AT_KLD);
            }
#pragma unroll
            for (int dt = 0; dt < 4; ++dt) {
                const bf16x8 a = {vt0[dt][0], vt0[dt][1], vt0[dt][2], vt0[dt][3], vt1[dt][0], vt1[dt][1], vt1[dt][2], vt1[dt][3]};
                o[dt][0] = MFMA16(a, pf[0], o[dt][0]); o[dt][1] = MFMA16(a, pf[1], o[dt][1]);
            }
        }
#pragma unroll
        for (int qt = 0; qt < 2; ++qt) {
            LAS bf16* gp = GT + (q0 + 16 * qt + n) * AT_GLD + (wave >> 1) * 64 + 4 * qd;
#pragma unroll
            for (int dt = 0; dt < 4; ++dt) {
                const u32x2 gw = *(const LAS u32x2*)(gp + 16 * dt);
                typedef float at_f32x2 __attribute__((ext_vector_type(2)));
                const at_f32x2 ga = {bflo(gw.x), bfhi(gw.x)}, gb = {bflo(gw.y), bfhi(gw.y)}, iv = {inv[qt], inv[qt]}, nl = {-1.4426950408889634f, -1.4426950408889634f}, one = {1.f, 1.f};
                const at_f32x2 ta = ga * nl, tb = gb * nl;
                const at_f32x2 ea = (at_f32x2){__builtin_amdgcn_exp2f(ta.x), __builtin_amdgcn_exp2f(ta.y)} + one, eb = (at_f32x2){__builtin_amdgcn_exp2f(tb.x), __builtin_amdgcn_exp2f(tb.y)} + one;
                const at_f32x2 ra = {__builtin_amdgcn_rcpf(ea.x), __builtin_amdgcn_rcpf(ea.y)}, rb = {__builtin_amdgcn_rcpf(eb.x), __builtin_amdgcn_rcpf(eb.y)};
                const at_f32x2 ya = (at_f32x2){o[dt][qt][0], o[dt][qt][1]} * (iv * ga) * ra, yb = (at_f32x2){o[dt][qt][2], o[dt][qt][3]} * (iv * gb) * rb;
                *(LAS u32x2*)(gp + 16 * dt) = (u32x2){pkbf(ya.x, ya.y), pkbf(yb.x, yb.y)};
            }
        }
        asm volatile("s_waitcnt lgkmcnt(0)" ::: "memory");
#pragma unroll
        for (int i = 0; i < 4; ++i) {
            const int rr = 8 * i + (lane >> 3), pc = lane & 7;
            const v4u w = *(const LAS v4u*)(GT + (q0 + rr) * AT_GLD + (wave >> 1) * 64 + 8 * pc);
            *(v4u*)(Y + (m0 + rr) * 2048 + 1024 + hq * 64 + 8 * pc) = w;
        }
    }
}

constexpr int SG_LD = 136, SG_VOFF = 34816, SG_OOFF = 69632, SG_OLD = 132;
typedef short sg_s16x4 __attribute__((ext_vector_type(4)));
__device__ __forceinline__ sg_s16x4 sg_tr(const LAS bf16* p) { return __builtin_bit_cast(sg_s16x4, __builtin_amdgcn_ds_read_tr16_b64_v4i16((LAS sg_s16x4*)p)); }
__device__ __forceinline__ void sgu_v2(LAS unsigned char* lds, const SguP P, const bf16* Z, bf16* Y, int G, const int tid, const int wave) {
    LAS bf16* WM = (LAS bf16*)lds; LAS bf16* VVT = (LAS bf16*)(lds + SG_VOFF);
    const int ng = G / 16; if ((int)blockIdx.x >= ng * 16) return;
    const int g = blockIdx.x & 15;
    __syncthreads();
    {
        float wv[32];
#pragma unroll
        for (int i = 0; i < 32; ++i) wv[i] = P.ws[(size_t)g * 16384 + tid + 512 * i];
#pragma unroll
        for (int i = 0; i < 32; ++i) { const int idx = tid + 512 * i, t = idx >> 7, s = idx & 127; WM[t * SG_LD + s] = (bf16)f2bf((t >= s) ? wv[i] : 0.f); }
    }
#define SG_BAR() asm volatile("s_waitcnt lgkmcnt(0)\n\ts_barrier" ::: "memory")
    LAS bf16* VN = VVT;
    const int tt0 = wave * 64 + (tid & 63), pc0 = tt0 & 15, rr0 = tt0 >> 4;
    const f32x4 lw0 = *(const f32x4*)(P.lnw + g * 128 + 8 * pc0), lw1 = *(const f32x4*)(P.lnw + g * 128 + 8 * pc0 + 4), lb0 = *(const f32x4*)(P.lnb + g * 128 + 8 * pc0), lb1 = *(const f32x4*)(P.lnb + g * 128 + 8 * pc0 + 4);
    v4u pv[4]; unsigned long long ps1[4], ps2[4];
    v4u nuw[4];
    LAS float* OT = (LAS float*)(lds + SG_OOFF);
    float bsr[4];
#pragma unroll
    for (int i = 0; i < 4; ++i) bsr[i] = P.bs[g * 128 + rr0 + 32 * i];
    {
        const int p0 = blockIdx.x >> 4;
        if (p0 < 128) { const size_t mm0 = (size_t)(p0 >> 6) * SEQ + (p0 & 63) * 128;
#pragma unroll
            for (int i = 0; i < 4; ++i) { const size_t m = mm0 + rr0 + 32 * i; pv[i] = *(const v4u*)(Z + m * ZO2 + 2048 + g * 128 + 8 * pc0); ps1[i] = P.st1[m]; ps2[i] = P.st2[m]; }
#pragma unroll
            for (int i = 0; i < 4; ++i) { const size_t m = mm0 + rr0 + 32 * i; nuw[i] = *(const v4u*)(Z + m * ZO2 + g * 128 + 8 * pc0); } }
    }
    SG_BAR();
    for (int p = blockIdx.x >> 4; p < 128; p += ng) {
        const int b = p >> 6, nc = p & 63; const size_t m0 = (size_t)b * SEQ + nc * 128;
        int lane = tid & 63; asm volatile("" : "+v"(lane));
        const int qd = lane >> 4, n = lane & 15;
        {
            const int tt_ = wave * 64 + lane; const int pc = tt_ & 15, rr = tt_ >> 4;
#pragma unroll
            for (int i = 0; i < 4; ++i) {
                const float mean = (float)(long long)ps1[i] * (1.0f / 16777216.0f) * (1.0f / 2048.0f), var = (float)(long long)ps2[i] * (1.0f / 16777216.0f) * (1.0f / 2048.0f) - mean * mean, rstd = __builtin_amdgcn_rsqf(var + 1e-5f);
                const v4u w = pv[i];
                const f32x4 x0 = {bflo(w.x), bfhi(w.x), bflo(w.y), bfhi(w.y)}, x1 = {bflo(w.z), bfhi(w.z), bflo(w.w), bfhi(w.w)};
                const f32x4 y0 = (x0 - mean) * rstd * lw0 + lb0, y1 = (x1 - mean) * rstd * lw1 + lb1;
                *(LAS v4u*)(VN + (rr + 32 * i) * SG_LD + 8 * pc) = (v4u){pkbf(y0[0], y0[1]), pkbf(y0[2], y0[3]), pkbf(y1[0], y1[1]), pkbf(y1[2], y1[3])};
            }
            const int pn = p + ng;
            if (pn < 128) { const size_t mm0 = (size_t)(pn >> 6) * SEQ + (pn & 63) * 128;
#pragma unroll
                for (int i = 0; i < 4; ++i) { const size_t m = mm0 + rr + 32 * i; pv[i] = *(const v4u*)(Z + m * ZO2 + 2048 + g * 128 + 8 * pc); ps1[i] = P.st1[m]; ps2[i] = P.st2[m]; } }
        }
        const int pcu = (wave * 64 + lane) & 15, rru = (wave * 64 + lane) >> 4;
        v4u uw[4];
#pragma unroll
        for (int i = 0; i < 4; ++i) uw[i] = nuw[i];
        { const int pn = p + ng; if (pn < 128) { const size_t mm0 = (size_t)(pn >> 6) * SEQ + (pn & 63) * 128;
#pragma unroll
            for (int i = 0; i < 4; ++i) { const size_t m = mm0 + rru + 32 * i; nuw[i] = *(const v4u*)(Z + m * ZO2 + g * 128 + 8 * pcu); } } }
        SG_BAR();
        f32x4 acc[8];
#pragma unroll
        for (int tt = 0; tt < 8; ++tt) acc[tt] = (f32x4){0.f, 0.f, 0.f, 0.f};
#pragma unroll
        for (int ks = 0; ks < 4; ++ks) {
            const LAS bf16* tp = VN + (32 * ks + 8 * qd + (n >> 2)) * SG_LD + 16 * wave + 4 * (n & 3);
            const sg_s16x4 t0 = sg_tr(tp), t1 = sg_tr(tp + 4 * SG_LD);
            bf16x8 bq[8];
#pragma unroll
            for (int tt = 2 * ks; tt < 8; ++tt) bq[tt] = ldfrag(WM + 16 * tt * SG_LD + 32 * ks, SG_LD, lane);
            const bf16x8 a = {t0[0], t0[1], t0[2], t0[3], t1[0], t1[1], t1[2], t1[3]};
#pragma unroll
            for (int tt = 2 * ks; tt < 8; ++tt) acc[tt] = MFMA16(a, bq[tt], acc[tt]);
        }
#pragma unroll
        for (int tt = 0; tt < 8; ++tt) *(LAS f32x4*)(OT + (16 * tt + n) * SG_OLD + 16 * wave + 4 * qd) = acc[tt];
        SG_BAR();
#pragma unroll
        for (int i = 0; i < 4; ++i) {
            const int t = rru + 32 * i; const size_t m = m0 + t; const float bsv = bsr[i];
            const f32x4 o0 = *(const LAS f32x4*)(OT + t * SG_OLD + 8 * pcu), o1 = *(const LAS f32x4*)(OT + t * SG_OLD + 8 * pcu + 4);
            const v4u w = uw[i];
            const f32x4 u0 = {bflo(w.x), bfhi(w.x), bflo(w.y), bfhi(w.y)}, u1 = {bflo(w.z), bfhi(w.z), bflo(w.w), bfhi(w.w)};
            const f32x4 y0 = u0 * (o0 + bsv), y1 = u1 * (o1 + bsv);
            *(v4u*)(Y + m * 2048 + g * 128 + 8 * pcu) = (v4u){pkbf(y0[0], y0[1]), pkbf(y0[2], y0[3]), pkbf(y1[0], y1[1]), pkbf(y1[2], y1[3])};
        }
    }
#undef SG_BAR
    __syncthreads();
}

struct Args { const void* in[27]; float* out; unsigned char* ws; int ph_lo, ph_hi, li, pad; };
enum { I_X = 0, I_POS, I_ENORM, I_EWIN, I_EMU, I_W0, I_W2, I_A0, I_A2, I_KK, I_KA, I_RK, I_LNW, I_LNB, I_V0, I_V1, I_V2, I_SINK, I_EWOUT, I_ONORM, I_OWIN, I_SLNW, I_SLNB, I_SWS, I_SBS, I_OWOUT, I_FNORM };

typedef const __attribute__((address_space(4))) Args* KArgP;
__device__ __forceinline__ KArgP kargs() { KArgP p = (KArgP)__builtin_amdgcn_kernarg_segment_ptr(); asm volatile("" : "+s"(p)); return p; }
__global__ void __launch_bounds__(NWAVES * 64, 2) hybrid_fwd(Args args_) {
    extern __shared__ __attribute__((aligned(16))) unsigned char lds_raw[];
    LAS unsigned char* lds = (LAS unsigned char*)lds_raw;
    volatile LAS unsigned* MISC = (volatile LAS unsigned*)(lds + MISC_OFF);
    const int wave = __builtin_amdgcn_readfirstlane(threadIdx.x >> 6);
    const int G = gridDim.x, gw = blockIdx.x * NWAVES + wave, NGW = G * NWAVES, NGT = G * NWAVES * 64;
    (void)args_;

    for (int u = threadIdx.x; u < (LDS_BYTES - LDSCTL_OFF) / 4; u += NWAVES * 64) ((LAS unsigned*)(lds + LDSCTL_OFF))[u] = 0u;
    __syncthreads();
    XcdBarrier bar; { KArgP a0 = kargs(); bar = xcd_barrier_post((unsigned*)(a0->ws + WS_CTL) + CW_BAR + a0->li * XCD_BAR_WORDS, MISC + 8); }
    LAS float* scr = (LAS float*)(lds + RING_OFF + wave * 16640);

    const int ph_lo = kargs()->ph_lo, ph_hi = kargs()->ph_hi;
    for (int ph = ph_lo; ph < ph_hi; ++ph) {
        KArgP args = kargs();
        int lane = (int)__builtin_amdgcn_mbcnt_hi(~0u, __builtin_amdgcn_mbcnt_lo(~0u, 0u)); asm volatile("" : "+v"(lane));
        const int tid = wave * 64 + lane, gtid = blockIdx.x * (NWAVES * 64) + tid;
        unsigned char* ws = args->ws;
        unsigned long long* STAT = (unsigned long long*)(ws + WS_STAT);
        float* COS = (float*)(ws + WS_ROPE); float* SIN = COS + (size_t)M * 8;
        bf16* WEIN = (bf16*)(ws + WS_WEIN); bf16* WOIN = (bf16*)(ws + WS_WOIN); bf16* WEOUT = (bf16*)(ws + WS_WEOUT); bf16* WOOUT = (bf16*)(ws + WS_WOOUT);
        bf16* XB = (bf16*)(ws + WS_XB); bf16* Y = (bf16*)(ws + WS_Y); bf16* VF = (bf16*)(ws + WS_VF); bf16* Z = (bf16*)(ws + WS_Z);
        const float* x_in = (const float*)args->in[I_X]; float* out = args->out;
        const int ptype = (int)((PH_TYPE >> (4 * ph)) & 15), L = (int)((PH_LAYER >> (4 * ph)) & 15), idx = L >> 1; const bool even = (L & 1) == 0;
        float* MG = out;
        if (ptype == 0) {
            for (int i = gtid; i < 8 * M; i += NGT) STAT[M + i] = 0ull;
            for (int m = gw; m < M; m += NGW) {
                const GAS f32x4* xr = (const GAS f32x4*)(x_in + (size_t)m * DM) + lane; GAS unsigned long long* o8 = (GAS unsigned long long*)(XB + (size_t)m * DM) + lane; float s = 0.f;
                const f32x4 v0 = xr[0], v1 = xr[64], v2 = xr[128], v3 = xr[192], v4 = xr[256], v5 = xr[320], v6 = xr[384], v7 = xr[448];
                asm volatile("s_waitcnt vmcnt(0)" ::: "memory");
#define P0_ROW(v, j) { s += ((v).x * (v).x + (v).y * (v).y) + ((v).z * (v).z + (v).w * (v).w); o8[64 * (j)] = (unsigned long long)pkbf((v).x, (v).y) | ((unsigned long long)pkbf((v).z, (v).w) << 32); }
                P0_ROW(v0, 0) P0_ROW(v1, 1) P0_ROW(v2, 2) P0_ROW(v3, 3) P0_ROW(v4, 4) P0_ROW(v5, 5) P0_ROW(v6, 6) P0_ROW(v7, 7)
#undef P0_ROW
                s = wave_sum(s); if (lane == 0) STAT[m] = (unsigned long long)(long long)(s * 16777216.0f);
            }
            { const int* pos = (const int*)args->in[I_POS];
              for (int i = gtid; i < M * 8; i += NGT) { const int m = i >> 3, k = i & 7; const float invf = powf(500000.0f, -(float)k * 0.125f); const float ang = (float)pos[m] * invf; COS[i] = cosf(ang); SIN[i] = sinf(ang); } }
            conv_weight((const float*)args->in[I_EWIN], ECOLS, (const float*)args->in[I_ENORM], WEIN, 1, scr, gw, NGW, lane);
            zero_rows(WEIN, ZC_E1, ZC_Q, gtid, NGT);
            if (G != 256) { const int r1 = (32 * (ECOLS / 64)) % NGW, r2 = (r1 + 1024) % NGW, r3 = (r2 + 1024) % NGW, r4 = (r3 + 1024) % NGW;
              conv_weight((const float*)args->in[I_EWOUT], 2048, nullptr, WEOUT, 0, scr, (gw + NGW - r1) % NGW, NGW, lane);
              conv_weight((const float*)args->in[I_EWOUT] + (size_t)2048 * 2048, 2048, nullptr, WEOUT + (size_t)2048 * 2048, 0, scr, (gw + NGW - r2) % NGW, NGW, lane);
              conv_weight((const float*)args->in[I_OWOUT], 2048, nullptr, WOOUT, 0, scr, (gw + NGW - r3) % NGW, NGW, lane);
              conv_weight((const float*)args->in[I_OWOUT] + (size_t)2048 * 2048, 2048, nullptr, WOOUT + (size_t)2048 * 2048, 0, scr, (gw + NGW - r4) % NGW, NGW, lane); }
        } else if (ptype == 5) {
            const float* fn = (const float*)args->in[I_FNORM]; const unsigned long long* ssq = STAT + (size_t)4 * M;
            {
                const GAS f32x4* gr = (const GAS f32x4*)fn + 2 * lane;
                const f32x4 g0 = gr[0], g1 = gr[1], g2 = gr[128], g3 = gr[129], g4 = gr[256], g5 = gr[257], g6 = gr[384], g7 = gr[385];
                for (int m = gw; m < M; m += NGW) {
                    const GAS v4u* xr = (const GAS v4u*)(XB + (size_t)m * DM) + lane; GAS f32x4* orow = (GAS f32x4*)(out + (size_t)m * DM) + 2 * lane;
                    const v4u w0 = xr[0], w1 = xr[64], w2 = xr[128], w3 = xr[192]; const unsigned long long sc = ssq[m];
                    asm volatile("s_waitcnt vmcnt(0)" ::: "memory");
                    const float rs = 1.0f / sqrtf((float)(long long)sc * (1.0f / 16777216.0f) * (1.0f / 2048.0f) + 1e-5f);
#define FN_ROW(q_, j, ga, gb) { orow[128 * (j)] = (f32x4){bflo((q_).x), bfhi((q_).x), bflo((q_).y), bfhi((q_).y)} * rs * (ga); orow[128 * (j) + 1] = (f32x4){bflo((q_).z), bfhi((q_).z), bflo((q_).w), bfhi((q_).w)} * rs * (gb); }
                    FN_ROW(w0, 0, g0, g1) FN_ROW(w1, 1, g2, g3) FN_ROW(w2, 2, g4, g5) FN_ROW(w3, 3, g6, g7)
#undef FN_ROW
                }
            }
        } else {
            if (ptype == 1) {
                const int N = even ? ZE : ZO;
                pg8::Gemm g{XB, even ? WEIN : WOIN, M, N, DM}; pg8::StaticOrder S; S.init(M, N, G, (int)blockIdx.x);
                LAS float* rst = (LAS float*)(lds + RST_OFF);
                { const unsigned long long* ssq = STAT + (size_t)L * M; unsigned long long sv[4];
#pragma unroll
                  for (int i = 0; i < 4; ++i) { pg8::Unit uu; const int ui = (tid >> 8) + 2 * i; const bool ok = S.next(ui, uu); sv[i] = ssq[(ok ? uu.pm : 0) * 256 + (tid & 255)]; }
#pragma unroll
                  for (int i = 0; i < 4; ++i) { const int ui = (tid >> 8) + 2 * i; rst[ui * 256 + (tid & 255)] = __builtin_amdgcn_rsqf((float)(long long)sv[i] * (1.0f / 16777216.0f) * (1.0f / 2048.0f) + 1e-5f); }
                  __syncthreads(); }
                pg8::EpiZ E{Z, even ? ZE : ZO2, lds + RST_OFF + 8192, rst, STAT + (size_t)(5 + idx) * M, STAT + (size_t)(7 + idx) * M, even ? 0 : 16, even ? 0 : 24, even ? 0 : 16};
                pg8::gemm_phase<pg8::EpiZ, pg8::StaticOrder, PG8_ALIGN, PG8_SP2>(lds + RING_OFF, g, S, E, tid);
                if (even && (int)blockIdx.x >= 192 && G == 256) {
                    const int sgw = ((int)blockIdx.x - 192) * NWAVES + wave;
                    conv_weight((const float*)args->in[I_OWIN] + (size_t)idx * 2048 * OCOLS, OCOLS, (const float*)args->in[I_ONORM] + idx * 2048, WOIN, 2, scr, sgw, 64 * NWAVES, lane);
                    conv_weight((const float*)args->in[I_EWOUT] + (size_t)idx * 2048 * 2048, 2048, nullptr, WEOUT + (size_t)idx * 2048 * 2048, 0, scr, sgw, 64 * NWAVES, lane);
                    conv_weight((const float*)args->in[I_OWOUT] + (size_t)idx * 2048 * 2048, 2048, nullptr, WOOUT + (size_t)idx * 2048 * 2048, 0, scr, sgw, 64 * NWAVES, lane);
                }
                else if (even && G != 256)
                    conv_weight((const float*)args->in[I_OWIN] + (size_t)idx * 2048 * OCOLS, OCOLS, (const float*)args->in[I_ONORM] + idx * 2048, WOIN, 2, scr, gw, NGW, lane);
            } else if (ptype == 4) {
                pg8::Gemm g{Y, (even ? WEOUT : WOOUT) + (size_t)idx * 2048 * 2048, M, DM, DM}; pg8::StaticOrder S; S.init(M, DM, G, (int)blockIdx.x);
                pg8::EpiX E{XB, STAT + (size_t)(L + 1) * M, lds + RST_OFF + 8192};
                pg8::gemm_phase<pg8::EpiX, pg8::StaticOrder, PG8_ALIGN, PG8_SP2>(lds + RING_OFF, g, S, E, tid);
            } else if (even) {
                RwkvP P; P.e = idx;
                P.mu = (const float*)args->in[I_EMU] + idx * 3200; P.w0 = (const float*)args->in[I_W0] + idx * 1024; P.w2 = (const float*)args->in[I_W2] + (size_t)idx * 64 * 1024;
                P.a0 = (const float*)args->in[I_A0] + idx * 1024; P.a2 = (const float*)args->in[I_A2] + (size_t)idx * 64 * 1024; P.kk = (const float*)args->in[I_KK] + idx * 1024; P.ka = (const float*)args->in[I_KA] + idx * 1024;
                P.rk = (const float*)args->in[I_RK] + idx * 1024; P.lnw = (const float*)args->in[I_LNW] + idx * 1024; P.lnb = (const float*)args->in[I_LNB] + idx * 1024;
                P.v0 = (const float*)args->in[I_V0]; P.v2 = (const float*)args->in[I_V2];
                if (ptype == 2) {
                    if (idx == 0) {
                        conv_weight((const float*)args->in[I_EWIN] + (size_t)2048 * ECOLS, ECOLS, (const float*)args->in[I_ENORM] + 2048, WEIN, 1, scr, gw, NGW, lane);
                        zero_rows(WEIN, ZC_E2 + 32, ZC_Q, gtid, NGT);
                        conv_e12_mfma(lds + RING_OFF, (const float*)args->in[I_EWIN] + (size_t)2048 * ECOLS, (const float*)args->in[I_ENORM] + 2048, (const float*)args->in[I_EMU] + 3200 + 2048, (const float*)args->in[I_V1], WEIN, tid, wave);
                        __syncthreads();
                    }
                    for (int u = blockIdx.x; u < 256; u += G) rwkv_v2(lds + RING_OFF, P, u >> 7, (u >> 3) & 15, u & 7, 0, Z, Y, VF, MG, (unsigned char*)out + 16 * MiB, tid, wave);
                } else {
                    for (int u = blockIdx.x; u < 256; u += G) rwkv_v2(lds + RING_OFF, P, u >> 7, (u >> 3) & 15, u & 7, 1, Z, Y, VF, MG, (unsigned char*)out + 16 * MiB, tid, wave);
                    const float* sinks = (const float*)args->in[I_SINK] + idx * 16;
                    for (int u = (int)blockIdx.x; u < 512; u += G) attn_v2_unit(lds + RING_OFF, u >> 8, (u >> 6) & 3, u & 63, Z, Y, COS, SIN, sinks, tid, wave);
                }
            } else {
                SguP P; P.lnw = (const float*)args->in[I_SLNW] + idx * 2048; P.lnb = (const float*)args->in[I_SLNB] + idx * 2048; P.ws = (const float*)args->in[I_SWS] + (size_t)idx * 16 * 16384; P.bs = (const float*)args->in[I_SBS] + idx * 2048;
                P.st1 = STAT + (size_t)(5 + idx) * M; P.st2 = STAT + (size_t)(7 + idx) * M;
                sgu_v2(lds + RING_OFF, P, Z, Y, G, tid, wave);
            }
        }
        if (ph + 1 < ph_hi) xcd_barrier(bar, tid);
    }
}

extern "C" void kernel_launch(void* const* d_in, const int* in_sizes, int n_in, void* d_out, int out_size, void* d_ws, size_t ws_size, hipStream_t stream) {
    static int grid = 0;
    if (grid == 0) {
        if (n_in != 27 || in_sizes[0] != M * DM || out_size != M * DM || ws_size < WS_END) { fprintf(stderr, "kernel_launch: unexpected shapes (n_in %d, in0 %d, out %d, ws %zu); nothing launched\n", n_in, n_in > 0 ? in_sizes[0] : -1, out_size, ws_size); grid = -1; return; }
        int dev = 0, cus = 0, per_cu = 0;
        if (hipGetDevice(&dev) != hipSuccess || hipDeviceGetAttribute(&cus, hipDeviceAttributeMultiprocessorCount, dev) != hipSuccess) { fprintf(stderr, "kernel_launch: device query failed\n"); grid = -1; return; }
        if (hipFuncSetAttribute((const void*)hybrid_fwd, hipFuncAttributeMaxDynamicSharedMemorySize, LDS_BYTES) != hipSuccess) { fprintf(stderr, "kernel_launch: hipFuncSetAttribute failed\n"); grid = -1; return; }
        if (hipOccupancyMaxActiveBlocksPerMultiprocessor(&per_cu, (const void*)hybrid_fwd, NWAVES * 64, LDS_BYTES) != hipSuccess || per_cu < 1) fprintf(stderr, "kernel_launch: note: occupancy query reports %d workgroups per CU\n", per_cu);
        (void)hipGetLastError();
        grid = cus;
    }
    if (grid < 0) return;
    if (hipMemsetAsync((char*)d_ws + WS_CTL, 0, CTL_ZERO_BYTES, stream) != hipSuccess) { fprintf(stderr, "kernel_launch: memset failed\n"); return; }
    Args a{};
    for (int i = 0; i < 27; ++i) a.in[i] = d_in[i];
    a.out = (float*)d_out; a.ws = (unsigned char*)d_ws;
#if ONE_LAUNCH
    a.ph_lo = 0; a.ph_hi = N_PHASES; a.li = 0;
    hipLaunchKernelGGL(hybrid_fwd, dim3(grid), dim3(NWAVES * 64), LDS_BYTES, stream, a);
#else
    for (int p = 0; p < N_PHASES; ++p) { a.ph_lo = p; a.ph_hi = p + 1; a.li = p; hipLaunchKernelGGL(hybrid_fwd, dim3(grid), dim3(NWAVES * 64), LDS_BYTES, stream, a); }
#endif
    const hipError_t le = hipPeekAtLastError();
    if (le != hipSuccess) fprintf(stderr, "kernel_launch: launch failed: %s\n", hipGetErrorName(le));
}
```
